# Optimizing an MI355X kernel written in HIP

```python
import jax, jax.numpy as jnp
from jax import lax
import numpy as np

D_MODEL = 1024
BATCH = 2
SEQ = 8192
DEPTH = 2

CHUNK = 64
N_META = 16
D_MIX = D_MODEL
D_POOL = D_MIX // 4
D_CONV = D_MIX // 4
D_RET = D_MIX - D_POOL - D_CONV
POOL_WINDOWS = (2, 4, 8, 16)
N_POOL_GROUPS = len(POOL_WINDOWS)
POOL_GROUP = D_POOL // N_POOL_GROUPS
CONV_WIDTH = 31
RET_HEADS = 4
RET_HEAD_DIM = D_RET // RET_HEADS
ROPE_BASE = 10000.0
D_FF = ((8 * D_MODEL // 3 + 63) // 64) * 64
D_IN = D_POOL + 2 * D_CONV + 4 * D_RET
DEEPNORM_ALPHA = (2.0 * DEPTH) ** 0.25
DEEPNORM_BETA = (8.0 * DEPTH) ** -0.25
LN_EPS = 1e-5

kernel_name = "hybrid_pool_conv_retention_deepnorm_trunk"


def layer_norm(x, g, b):
    xf = x.astype(jnp.float32)
    mu = jnp.mean(xf, axis=-1, keepdims=True)
    var = jnp.mean(jnp.square(xf - mu), axis=-1, keepdims=True)
    return ((xf - mu) * lax.rsqrt(var + LN_EPS) * g + b).astype(x.dtype)


def swiglu_ffn(x, w13, w2):
    a, u = jnp.split(x @ w13, 2, axis=-1)
    return (jax.nn.silu(a) * u) @ w2


def pool_mixer(xp, w_pool, scale):
    B, L, _ = xp.shape
    xf = xp.astype(jnp.float32)
    cs = jnp.concatenate([jnp.zeros((B, 1, D_POOL), jnp.float32), jnp.cumsum(xf, axis=1)], axis=1)
    t = jnp.arange(L)
    outs = []
    for gi, w in enumerate(POOL_WINDOWS):
        lo, hi = gi * POOL_GROUP, (gi + 1) * POOL_GROUP
        csg = cs[..., lo:hi]
        start = jnp.maximum(t + 1 - w, 0)
        win_sum = csg[:, 1:] - csg[:, start]
        count = (t + 1 - start).astype(jnp.float32)
        outs.append(win_sum / count[None, :, None] - xf[..., lo:hi])
    y = jnp.stack(outs, axis=2)
    y = jnp.einsum('blgc,gcd->blgd', y, w_pool.astype(jnp.float32)).reshape(B, L, D_POOL)
    return (y * scale).astype(xp.dtype)


def conv_module(a, gate, w_dw, b_dw, ln_g, ln_b, w_pw):
    u = a * jax.nn.sigmoid(gate)
    y = lax.conv_general_dilated(u, w_dw[:, None, :], window_strides=(1,),
                                 padding=[(CONV_WIDTH - 1, 0)],
                                 dimension_numbers=('NWC', 'WIO', 'NWC'),
                                 feature_group_count=D_CONV) + b_dw
    y = jax.nn.silu(layer_norm(y, ln_g, ln_b))
    return y @ w_pw


def rope(x, cos, sin):
    x1, x2 = jnp.split(x, 2, axis=-1)
    return jnp.concatenate([x1 * cos - x2 * sin, x2 * cos + x1 * sin], axis=-1)


def retention(q, k, v, g, gn_g):
    B, L, _ = q.shape
    f32 = jnp.float32
    pos = jnp.arange(L, dtype=f32)
    inv_freq = ROPE_BASE ** (-jnp.arange(0, RET_HEAD_DIM, 2, dtype=f32) / RET_HEAD_DIM)
    ang = pos[:, None] * inv_freq[None, :]
    cos, sin = jnp.cos(ang), jnp.sin(ang)
    heads = lambda t: t.astype(f32).reshape(B, L, RET_HEADS, RET_HEAD_DIM).transpose(0, 2, 1, 3)
    qh = rope(heads(q), cos, sin)
    kh = rope(heads(k), cos, sin) * (RET_HEAD_DIM ** -0.5)
    vh = heads(v)
    P = (-N_META) % CHUNK
    NC = (L + P) // CHUNK
    chunk = lambda t: jnp.pad(t, ((0, 0), (0, 0), (P, 0), (0, 0))).reshape(B, RET_HEADS, NC, CHUNK, RET_HEAD_DIM)
    qc, kc, vc = chunk(qh), chunk(kh), chunk(vh)
    log_gamma = jnp.log(1.0 - 2.0 ** (-5.0 - jnp.arange(RET_HEADS, dtype=f32)))
    i = jnp.arange(CHUNK, dtype=f32)
    intra_decay = jnp.exp(log_gamma[:, None, None] * jnp.abs(i[:, None] - i[None, :]))
    s = jnp.einsum('bhnid,bhnjd->bhnij', qc, kc) * intra_decay[None, :, None]
    o_intra = jnp.einsum('bhnij,bhnjd->bhnid', s, vc)
    q_decay = jnp.exp(log_gamma[:, None] * (i + 1.0))[None, :, :, None]
    k_decay = jnp.exp(log_gamma[:, None] * (CHUNK - 1.0 - i))[None, :, :, None]
    chunk_decay = jnp.exp(log_gamma * CHUNK)[None, :, None, None]

    def step(state, inp):
        q_n, k_n, v_n = inp
        o = jnp.einsum('bhid,bhde->bhie', q_n * q_decay, state)
        state = state * chunk_decay + jnp.einsum('bhjd,bhje->bhde', k_n * k_decay, v_n)
        return state, o

    to_scan = lambda t: t.transpose(2, 0, 1, 3, 4)
    state0 = jnp.zeros((B, RET_HEADS, RET_HEAD_DIM, RET_HEAD_DIM), f32)
    _, o_cross = lax.scan(step, state0, (to_scan(qc), to_scan(kc), to_scan(vc)))
    o = o_intra + o_cross.transpose(1, 2, 0, 3, 4)
    o = o.reshape(B, RET_HEADS, NC * CHUNK, RET_HEAD_DIM)[:, :, P:]
    mu = jnp.mean(o, axis=-1, keepdims=True)
    var = jnp.mean(jnp.square(o - mu), axis=-1, keepdims=True)
    o = ((o - mu) * lax.rsqrt(var + LN_EPS)).transpose(0, 2, 1, 3).reshape(B, L, D_RET) * gn_g
    return (jax.nn.silu(g.astype(f32)) * o).astype(g.dtype)


def token_mix(h, w_in, pool_w, pool_scale, conv_dw, conv_db, conv_ln_g, conv_ln_b, conv_pw, ret_gn_g, w_out):
    z = h @ w_in
    splits = [D_POOL, D_POOL + D_CONV, D_POOL + 2 * D_CONV,
              D_POOL + 2 * D_CONV + D_RET, D_POOL + 2 * D_CONV + 2 * D_RET,
              D_POOL + 2 * D_CONV + 3 * D_RET]
    xp, ca, cg, q, k, v, g = jnp.split(z, splits, axis=-1)
    y_pool = pool_mixer(xp, pool_w, pool_scale)
    y_conv = conv_module(ca, cg, conv_dw, conv_db, conv_ln_g, conv_ln_b, conv_pw)
    y_ret = retention(q, k, v, g, ret_gn_g)
    return jnp.concatenate([y_pool, y_conv, y_ret], axis=-1) @ w_out


def setup_inputs(seed: int = 0) -> dict:
    key = jax.random.key(seed)
    ks = jax.random.split(key, 24)
    nrm = lambda k, shape, s: jax.random.normal(k, shape, jnp.float32) * s
    ones_n = lambda k, shape: 1.0 + 0.05 * jax.random.normal(k, shape, jnp.float32)
    return {
        "x": nrm(ks[0], (BATCH, SEQ, D_MODEL), 1.0),
        "meta": nrm(ks[1], (N_META, D_MODEL), 1.0),
        "ln_in_g": ones_n(ks[2], (D_MODEL,)),
        "ln_in_b": nrm(ks[3], (D_MODEL,), 0.02),
        "ffn1_w13": nrm(ks[4], (DEPTH, D_MODEL, 2 * D_FF), D_MODEL ** -0.5),
        "ffn1_w2": nrm(ks[5], (DEPTH, D_FF, D_MODEL), DEEPNORM_BETA * D_FF ** -0.5),
        "w_in": nrm(ks[6], (DEPTH, D_MODEL, D_IN), D_MODEL ** -0.5),
        "pool_w": nrm(ks[7], (DEPTH, N_POOL_GROUPS, POOL_GROUP, POOL_GROUP), POOL_GROUP ** -0.5),
        "pool_scale": ones_n(ks[8], (DEPTH, D_POOL)),
        "conv_dw": nrm(ks[9], (DEPTH, CONV_WIDTH, D_CONV), CONV_WIDTH ** -0.5),
        "conv_db": nrm(ks[10], (DEPTH, D_CONV), 0.02),
        "conv_ln_g": ones_n(ks[11], (DEPTH, D_CONV)),
        "conv_ln_b": nrm(ks[12], (DEPTH, D_CONV), 0.02),
        "conv_pw": nrm(ks[13], (DEPTH, D_CONV, D_CONV), D_CONV ** -0.5),
        "ret_gn_g": ones_n(ks[14], (DEPTH, D_RET)),
        "w_out": nrm(ks[15], (DEPTH, D_MIX, D_MODEL), DEEPNORM_BETA * D_MIX ** -0.5),
        "ffn2_w13": nrm(ks[16], (DEPTH, D_MODEL, 2 * D_FF), D_MODEL ** -0.5),
        "ffn2_w2": nrm(ks[17], (DEPTH, D_FF, D_MODEL), DEEPNORM_BETA * D_FF ** -0.5),
        "ln_g": ones_n(ks[18], (DEPTH, 3, D_MODEL)),
        "ln_b": nrm(ks[19], (DEPTH, 3, D_MODEL), 0.02),
    }


def reference(x, meta, ln_in_g, ln_in_b, ffn1_w13, ffn1_w2, w_in, pool_w, pool_scale,
              conv_dw, conv_db, conv_ln_g, conv_ln_b, conv_pw, ret_gn_g, w_out,
              ffn2_w13, ffn2_w2, ln_g, ln_b):
    B = x.shape[0]
    h = jnp.concatenate([jnp.broadcast_to(meta[None].astype(x.dtype), (B, N_META, D_MODEL)), x], axis=1)
    h = layer_norm(h, ln_in_g, ln_in_b)
    for l in range(DEPTH):
        h = layer_norm(DEEPNORM_ALPHA * h + 0.5 * swiglu_ffn(h, ffn1_w13[l], ffn1_w2[l]), ln_g[l, 0], ln_b[l, 0])
        mix = token_mix(h, w_in[l], pool_w[l], pool_scale[l], conv_dw[l], conv_db[l],
                        conv_ln_g[l], conv_ln_b[l], conv_pw[l], ret_gn_g[l], w_out[l])
        h = layer_norm(DEEPNORM_ALPHA * h + mix, ln_g[l, 1], ln_b[l, 1])
        h = layer_norm(DEEPNORM_ALPHA * h + 0.5 * swiglu_ffn(h, ffn2_w13[l], ffn2_w2[l]), ln_g[l, 2], ln_b[l, 2])
    return h[:, N_META:]
```

```cpp
#include <hip/hip_runtime.h>
#include <hip/hip_cooperative_groups.h>
#include <cstdio>
#include <cstdint>
namespace cg = cooperative_groups;

#define LAS __attribute__((address_space(3)))
typedef unsigned short bf16_t;
typedef short bf16x8 __attribute__((ext_vector_type(8)));
typedef float f32x4 __attribute__((ext_vector_type(4)));
typedef float f32x16 __attribute__((ext_vector_type(16)));
typedef float f32x2 __attribute__((ext_vector_type(2)));
typedef unsigned u32x4 __attribute__((ext_vector_type(4)));
typedef unsigned u32x2 __attribute__((ext_vector_type(2)));

#ifndef EN_PRO
#define EN_PRO 1
#endif
#ifndef EN_UP
#define EN_UP 1
#endif
#ifndef EN_RES
#define EN_RES 1
#endif
#ifndef EN_IN
#define EN_IN 1
#endif
#ifndef EN_M1
#define EN_M1 1
#endif
#ifndef EN_M2
#define EN_M2 1
#endif
#ifndef PROBE_SET
#define PROBE_SET 0
#endif
#ifndef ONE_LAUNCH
#define ONE_LAUNCH 1
#endif

constexpr int D = 1024, SEQ = 8192, NMETA = 16, LSEQ = SEQ + NMETA, NB = 2;
constexpr int TM = NB * SEQ;
constexpr int T = TM + NB * NMETA;
constexpr int DFF = 2752, GW = 2816, NUP = 5632, DIN = 2816;
constexpr int NCHUNK = 129;
constexpr float ALPHA = 1.41421356237309515f;
constexpr float LN_EPS = 1e-5f;
constexpr int NPH = 19;
constexpr int GRID = 256;

constexpr size_t OFF_CTL = 0;
constexpr size_t OFF_CVEC = 16384;
constexpr size_t ZERO_BYTES = 524288;
constexpr size_t OFF_ZFM = 524288;
constexpr size_t OFF_STATS = OFF_ZFM + 32 * 1024 * 4;
constexpr size_t STATS_BYTES = (size_t)T * 32 * 4;
constexpr size_t OFF_ROPE = OFF_STATS + 2 * STATS_BYTES;
constexpr size_t OFF_PW = OFF_ROPE + (size_t)LSEQ * 64 * 8;
constexpr size_t OFF_PP = OFF_PW + 2 * 131072;
constexpr size_t OFF_WA = OFF_PP + 2 * 131072;
constexpr size_t W13_BYTES = (size_t)NUP * 1024 * 2, W2_BYTES = (size_t)1024 * GW * 2;
constexpr size_t OFF_WB = OFF_WA + W13_BYTES + W2_BYTES;
constexpr size_t OFF_WIO0 = OFF_WB + W13_BYTES + W2_BYTES;
constexpr size_t WIN_BYTES = (size_t)DIN * 1024 * 2, WOUT_BYTES = (size_t)1024 * 1024 * 2;
constexpr size_t OFF_WIO1 = OFF_WIO0 + WIN_BYTES + WOUT_BYTES;
constexpr size_t OFF_ZB = OFF_WIO1 + WIN_BYTES + WOUT_BYTES;
constexpr size_t OFF_R = OFF_ZB + (size_t)T * 1024 * 2;
constexpr size_t OFF_G = OFF_R;
constexpr size_t OFF_XP = OFF_R;
constexpr size_t OFF_U = OFF_XP + (size_t)T * 256 * 2;
constexpr size_t OFF_Q = OFF_U + (size_t)T * 256 * 2;
constexpr size_t OFF_K = OFF_Q + (size_t)T * 512 * 2;
constexpr size_t OFF_K2 = OFF_K + (size_t)T * 512 * 2;
constexpr size_t OFF_V = OFF_K2 + (size_t)T * 512 * 2;
constexpr size_t OFF_SG = OFF_V + (size_t)T * 512 * 2;
constexpr size_t OFF_YCAT = OFF_SG + (size_t)T * 512 * 2;
constexpr size_t OFF_ST = OFF_YCAT + (size_t)T * 1024 * 2;
constexpr size_t WS_END = OFF_ST + (size_t)NB * 4 * NCHUNK * 16384 * 2;
static_assert(OFF_G + (size_t)T * GW * 2 <= WS_END, "G fits");
static_assert(WS_END <= (size_t)268435456, "workspace budget");

constexpr int LDS_BYTES = 147456;
constexpr int MISC_OFF = 131072;
constexpr int CTAB_OFF = MISC_OFF + 1024;
typedef short v4i16_t __attribute__((ext_vector_type(4)));

__device__ __forceinline__ unsigned f2bf(float f) { unsigned u = __float_as_uint(f); return (u + 0x7fffu + ((u >> 16) & 1u)) >> 16; }
__device__ __forceinline__ float bf2f(unsigned h) { return __uint_as_float(h << 16); }
typedef __bf16 bf16x2_t __attribute__((ext_vector_type(2)));
__device__ __forceinline__ unsigned cvt_pk_bf16(float lo, float hi) { const f32x2 v = {lo, hi}; const bf16x2_t r = __builtin_convertvector(v, bf16x2_t); return __builtin_bit_cast(unsigned, r); }
__device__ __forceinline__ int lane_id_v() { int l; asm volatile("v_mbcnt_lo_u32_b32 %0, -1, 0\n\tv_mbcnt_hi_u32_b32 %0, -1, %0" : "=v"(l)); return l; }
__device__ __forceinline__ float shfl_i(float v, int src) { return __builtin_bit_cast(float, __builtin_amdgcn_ds_bpermute(src << 2, __builtin_bit_cast(int, v))); }
__device__ __forceinline__ float shfl_x(float v, int lane, int m) { return shfl_i(v, lane ^ m); }
__device__ __forceinline__ float wave_sum(float v, int lane) {
#pragma unroll
    for (int o = 1; o < 64; o <<= 1) v += shfl_x(v, lane, o);
    return v;
}
typedef long long cfix_t;
__device__ __forceinline__ float cfix2f(cfix_t v) { return (float)((double)v * (1.0 / 4294967296.0)); }
__device__ __forceinline__ f32x4 ldc4(const cfix_t* p) { const u32x4 a = *(const u32x4*)p, b = *(const u32x4*)(p + 2);
    return (f32x4){cfix2f((cfix_t)(((unsigned long long)a.y << 32) | a.x)), cfix2f((cfix_t)(((unsigned long long)a.w << 32) | a.z)), cfix2f((cfix_t)(((unsigned long long)b.y << 32) | b.x)), cfix2f((cfix_t)(((unsigned long long)b.w << 32) | b.z))}; }
__device__ __forceinline__ float fast_sigmoid(float x) { return __builtin_amdgcn_rcpf(1.0f + __builtin_amdgcn_exp2f(-1.4426950408889634f * x)); }
__device__ __forceinline__ float silu_f(float x) { return x * fast_sigmoid(x); }
__device__ __forceinline__ int tok_row(int b, int t) { return t < NMETA ? TM + NMETA * b + t : SEQ * b + t - NMETA; }
__device__ __forceinline__ void row_bt(int r, int& b, int& t) { if (r < TM) { b = r >> 13; t = (r & 8191) + NMETA; } else { const int m = r - TM; b = m >> 4; t = m & 15; } }
__device__ __forceinline__ float log2_gamma(int h) { return __log2f(1.0f - exp2f(-5.0f - (float)h)); }
__device__ __forceinline__ void stat_finish(float s, float ss, float& mu, float& rs) { mu = s * (1.f / 1024.f); const float var = ss * (1.f / 1024.f) - mu * mu; rs = rsqrtf(fmaxf(var, 0.f) + LN_EPS); }
__device__ __forceinline__ void load_row_stat(const float* stats, int r, float& mu, float& rs) {
    const f32x4* p = (const f32x4*)(stats + (size_t)r * 32); float s = 0.f, ss = 0.f;
#pragma unroll
    for (int k = 0; k < 8; ++k) { const f32x4 v = p[k]; s += v.x + v.z; ss += v.y + v.w; }
    stat_finish(s, ss, mu, rs);
}

struct UnitStats {
    float mu0, rs0, mu1, rs1;
    __device__ __forceinline__ void load(const float* stats, int rowbase, int lane) { load_row_stat(stats, rowbase + lane, mu0, rs0); load_row_stat(stats, rowbase + 128 + lane, mu1, rs1); }
    __device__ __forceinline__ void get(int ai, int m, int fr, float& mu, float& rs) const { const int src = 16 * m + fr; mu = shfl_i(ai ? mu1 : mu0, src); rs = shfl_i(ai ? rs1 : rs0, src); }
};

namespace pg8 {
constexpr int BM = 256, BK = 64, HALF = 128, HTB = HALF * BK * 2, STAGE_BYTES = 8 * HTB, NXCD = 8, WGM = 8;
__host__ __device__ __forceinline__ int lds_byte(int r, int c) { const int st = (r >> 4) * 2 + (c >> 5), rr = r & 15, cc = c & 31, ob = rr * 64 + cc * 2; return st * 1024 + (ob ^ (((ob >> 9) & 1) << 5)); }
__host__ __device__ __forceinline__ void stage_rc(int b, int& R, int& C) { const int st = b / 1024, sb = b % 1024, swz = sb ^ (((sb >> 9) & 1) << 5); R = (st >> 1) * 16 + swz / 64; C = (st & 1) * 32 + (swz % 64) / 2; }
__host__ __device__ __forceinline__ int perm32(int rho) { const int n = rho >> 4, i = rho & 15; return 8 * (i >> 2) + 4 * n + (i & 3); }
struct Unit { int pm, pn; };
struct Gemm { const bf16_t* A; const bf16_t* Bt; int K; };
struct StaticOrder {
    int nM, nN, nwg, G, c;
    __device__ void init(int M, int N, int G_, int c_) { nM = M / BM; nN = N / BM; nwg = nM * nN; G = G_; c = c_; }
    __device__ bool next(int i, Unit& u) const {
        const long L = (long)i * G + c; if (L >= nwg) return false;
        int wgid = (int)L; { const int q = nwg / NXCD, r = nwg % NXCD, xcd = wgid % NXCD, off = wgid / NXCD; wgid = (xcd < r ? xcd * (q + 1) : r * (q + 1) + (xcd - r) * q) + off; }
        const int nig = WGM * nN, gid = wgid / nig, fm = gid * WGM, gsz = (nM - fm) < WGM ? (nM - fm) : WGM;
        u.pm = __builtin_amdgcn_readfirstlane(fm + ((wgid % nig) % gsz)); u.pn = __builtin_amdgcn_readfirstlane((wgid % nig) / gsz); return true;
    }
};

template <class Epi>
__device__ __forceinline__ void gemm_phase(LAS unsigned char* lds, const Gemm g, const StaticOrder& S, const Epi& E, const int tid) {
    const int wid = __builtin_amdgcn_readfirstlane(tid >> 6), lane = tid & 63, wr = wid >> 2, wc = wid & 3, fr = lane & 15, fq = lane >> 4;
    const int K = g.K, nt = K / BK;
    unsigned voffA[2], voffB[2];
#pragma unroll
    for (int i = 0; i < 2; ++i) { int R, C; stage_rc(tid * 16 + i * 8192, R, C); const int Rb = Epi::PERM ? ((R & ~31) + perm32(R & 31)) : R;
        voffA[i] = (unsigned)(R * K + C) * 2u; voffB[i] = (unsigned)(Rb * K + C) * 2u; }
    const size_t kstep = (size_t)(BK * 2);
    const size_t hstep = (size_t)HALF * K * 2;
    const size_t tstep = 2 * hstep;
    const unsigned ldsw = (unsigned)wid * 1024u;
    const int aoff = lds_byte(wr * 64 + fr, fq * 8), boff = lds_byte(wc * 32 + fr, fq * 8);
#define PG8_SA(b, h) (((b) * 2 + (h)) * HTB)
#define PG8_SB(b, h) ((4 + (b) * 2 + (h)) * HTB)
#define PG8_STAGE(bufoff, gbase, voff) do { _Pragma("unroll") for (int _i = 0; _i < 2; ++_i) \
        __builtin_amdgcn_global_load_lds((const unsigned*)((const char*)(gbase) + (voff)[_i]), (LAS unsigned*)(lds + (bufoff) + ldsw + _i * 8192), 16, 0, 0); } while (0)
#define PG8_LDA(dst, b, h) do { _Pragma("unroll") for (int m = 0; m < 4; ++m) _Pragma("unroll") for (int k = 0; k < 2; ++k) dst[m][k] = *(const LAS bf16x8*)(lds + PG8_SA(b, h) + aoff + m * 2048 + k * 1024); } while (0)
#define PG8_LDB(dst, b, h) do { _Pragma("unroll") for (int n = 0; n < 2; ++n) _Pragma("unroll") for (int k = 0; k < 2; ++k) dst[n][k] = *(const LAS bf16x8*)(lds + PG8_SB(b, h) + boff + n * 2048 + k * 1024); } while (0)
#define PG8_MMA(ai, bj, At, Bt) do { __builtin_amdgcn_s_setprio(1); _Pragma("unroll") for (int m = 0; m < 4; ++m) _Pragma("unroll") for (int n = 0; n < 2; ++n) _Pragma("unroll") for (int k = 0; k < 2; ++k) \
        acc[ai][bj][m][n] = __builtin_amdgcn_mfma_f32_16x16x32_bf16(Bt[n][k], At[m][k], acc[ai][bj][m][n], 0, 0, 0); __builtin_amdgcn_s_setprio(0); } while (0)
#define PG8_WAIT_V(n) asm volatile("s_waitcnt vmcnt(" #n ")" ::: "memory")
#define PG8_WAIT_L(n) asm volatile("s_waitcnt lgkmcnt(" #n ")" ::: "memory")
#define PG8_BAR __builtin_amdgcn_s_barrier()
#define PG8_SCHED __builtin_amdgcn_sched_barrier(0)
    Unit cur, nxt; int ui = 0;
    if (!S.next(0, cur)) return;
    UnitStats stn;
    stn.load(E.stats, cur.pm * 256 + wr * 64, lane);
    f32x4 acc[2][2][4][2];
#pragma unroll
    for (int a = 0; a < 2; ++a)
#pragma unroll
        for (int b = 0; b < 2; ++b)
#pragma unroll
            for (int m = 0; m < 4; ++m)
#pragma unroll
                for (int n = 0; n < 2; ++n) acc[a][b][m][n] = (f32x4){0.f, 0.f, 0.f, 0.f};
    bf16x8 At[4][2], B0[2][2], B1[2][2];
    const char* cA = (const char*)g.A + (size_t)cur.pm * tstep; const char* cB = (const char*)g.Bt + (size_t)cur.pn * tstep;
    PG8_STAGE(PG8_SB(0, 0), cB, voffB); PG8_STAGE(PG8_SB(0, 1), cB + hstep, voffB); PG8_STAGE(PG8_SA(0, 0), cA, voffA); PG8_STAGE(PG8_SA(0, 1), cA + hstep, voffA);
    if (wr == 1) PG8_BAR;
    PG8_WAIT_V(2); PG8_BAR;
    PG8_STAGE(PG8_SB(1, 0), cB + kstep, voffB); PG8_STAGE(PG8_SA(1, 0), cA + kstep, voffA); PG8_STAGE(PG8_SB(1, 1), cB + hstep + kstep, voffB);
    PG8_WAIT_V(6); PG8_BAR;
    for (;;) {
        const bool has_next = S.next(ui + 1, nxt);
        const char* nA = has_next ? (const char*)g.A + (size_t)nxt.pm * tstep : cA; const char* nB = has_next ? (const char*)g.Bt + (size_t)nxt.pn * tstep : cB;
        for (int t = 0; t < nt; t += 2) {
            const bool last = (t == nt - 2);
            const char* a1 = cA + (size_t)(t + 1) * kstep;
            const char* a2 = last ? nA : cA + (size_t)(t + 2) * kstep; const char* b2 = last ? nB : cB + (size_t)(t + 2) * kstep;
            const char* a3 = a2 + kstep; const char* b3 = b2 + kstep;
            PG8_LDB(B0, 0, 0); PG8_LDB(B1, 0, 1); PG8_SCHED; PG8_LDA(At, 0, 0); PG8_STAGE(PG8_SA(1, 1), a1 + hstep, voffA);
            PG8_WAIT_V(8); PG8_WAIT_L(0); PG8_BAR; PG8_MMA(0, 0, At, B0); PG8_MMA(0, 1, At, B1); PG8_BAR; PG8_SCHED;
            PG8_LDA(At, 0, 1); PG8_STAGE(PG8_SB(0, 0), b2, voffB); PG8_STAGE(PG8_SB(0, 1), b2 + hstep, voffB); PG8_STAGE(PG8_SA(0, 0), a2, voffA);
            PG8_WAIT_V(8); PG8_WAIT_L(0); PG8_BAR; PG8_MMA(1, 0, At, B0); PG8_MMA(1, 1, At, B1); PG8_BAR; PG8_SCHED;
            PG8_LDB(B0, 1, 0); PG8_LDB(B1, 1, 1); PG8_SCHED; PG8_LDA(At, 1, 0); PG8_STAGE(PG8_SA(0, 1), a2 + hstep, voffA);
            PG8_WAIT_V(8); PG8_WAIT_L(0); PG8_BAR; PG8_MMA(0, 0, At, B0); PG8_MMA(0, 1, At, B1); PG8_BAR; PG8_SCHED;
            PG8_LDA(At, 1, 1); PG8_STAGE(PG8_SB(1, 0), b3, voffB); PG8_STAGE(PG8_SB(1, 1), b3 + hstep, voffB); PG8_STAGE(PG8_SA(1, 0), a3, voffA);
            PG8_WAIT_V(8); PG8_WAIT_L(0); PG8_BAR; PG8_MMA(1, 0, At, B0); PG8_MMA(1, 1, At, B1); PG8_BAR; PG8_SCHED;
        }
        if (wr == 0) PG8_BAR;
        { const int l2 = lane_id_v(); E(acc, cur, wr, wc, l2 & 15, l2 >> 4, stn, ui); if (has_next) stn.load(E.stats, nxt.pm * 256 + wr * 64, l2); }
        if (!has_next) break;
#pragma unroll
        for (int a = 0; a < 2; ++a)
#pragma unroll
            for (int b = 0; b < 2; ++b)
#pragma unroll
                for (int m = 0; m < 4; ++m)
#pragma unroll
                    for (int n = 0; n < 2; ++n) acc[a][b][m][n] = (f32x4){0.f, 0.f, 0.f, 0.f};
        cur = nxt; cA = nA; cB = nB; ++ui;
        if (wr == 1) PG8_BAR;
    }
    PG8_WAIT_V(0);
    PG8_BAR;
#undef PG8_SA
#undef PG8_SB
#undef PG8_STAGE
#undef PG8_LDA
#undef PG8_LDB
#undef PG8_MMA
#undef PG8_WAIT_V
#undef PG8_WAIT_L
#undef PG8_BAR
#undef PG8_SCHED
}
}


struct EpiUp {
    static constexpr bool PERM = true;
    const float* stats; const cfix_t* c1; const cfix_t* c2; unsigned char* ws; const LAS float* ctab;
    __device__ __forceinline__ void operator()(const f32x4 (&acc)[2][2][4][2], const pg8::Unit& u, int wr, int wc, int fr, int fq, const UnitStats& st, int ui) const {
        asm volatile("" : "+v"(fr), "+v"(fq));
        const int lane = fr + 16 * fq, rowbase = u.pm * 256 + wr * 64;
        const int n0 = u.pn * 256 + wc * 32 + 8 * fq, gcol = u.pn * 128 + wc * 32 + 8 * fq;
        bf16_t* G = (bf16_t*)(ws + OFF_G);
        f32x4 ka1[2], ka2[2], ku1[2], ku2[2];
#pragma unroll
        for (int n = 0; n < 2; ++n) { const LAS float* ct = ctab + ui * 512 + wc * 32 + 8 * fq + 4 * n; ka1[n] = *(const LAS f32x4*)ct; ka2[n] = *(const LAS f32x4*)(ct + 256); ku1[n] = *(const LAS f32x4*)(ct + 128); ku2[n] = *(const LAS f32x4*)(ct + 384); }
#pragma unroll
        for (int ai = 0; ai < 2; ++ai)
#pragma unroll
            for (int m = 0; m < 4; ++m) {
                float mu, rs; st.get(ai, m, fr, mu, rs);
                const int r = rowbase + 128 * ai + 16 * m + fr;
                float o[8];
#pragma unroll
                for (int n = 0; n < 2; ++n) {
#pragma unroll
                    for (int j = 0; j < 4; ++j) {
                        const float av = rs * (acc[ai][0][m][n][j] - mu * ka1[n][j]) + ka2[n][j];
                        const float uu = rs * (acc[ai][1][m][n][j] - mu * ku1[n][j]) + ku2[n][j];
                        o[4 * n + j] = silu_f(av) * uu;
                    }
                }
                u32x4 w; w.x = cvt_pk_bf16(o[0], o[1]); w.y = cvt_pk_bf16(o[2], o[3]); w.z = cvt_pk_bf16(o[4], o[5]); w.w = cvt_pk_bf16(o[6], o[7]);
                __builtin_nontemporal_store(w, (u32x4*)(G + (size_t)r * GW + gcol));
            }
    }
    __device__ __forceinline__ void tail(int u, int row, int c, float p0, float p1, float q0, float q1) const {
        const int r = TM + row, n0 = (u >> 2) * 256 + (u & 3) * 32 + c, gcol = (u >> 2) * 128 + (u & 3) * 32 + c;
        float mu, rs; load_row_stat(stats, r, mu, rs);
        const float a0 = rs * (p0 - mu * cfix2f(c1[n0])) + cfix2f(c2[n0]), a1 = rs * (p1 - mu * cfix2f(c1[n0 + 1])) + cfix2f(c2[n0 + 1]);
        const float u0 = rs * (q0 - mu * cfix2f(c1[n0 + 128])) + cfix2f(c2[n0 + 128]), u1 = rs * (q1 - mu * cfix2f(c1[n0 + 129])) + cfix2f(c2[n0 + 129]);
        *(unsigned*)((bf16_t*)(ws + OFF_G) + (size_t)r * GW + gcol) = cvt_pk_bf16(silu_f(a0) * u0, silu_f(a1) * u1);
    }
};

struct EpiRes {
    static constexpr bool PERM = false;
    const float* stats; float* stats_new; const float* lg; const float* lb; float* zf; unsigned char* ws; float bscale;
    int fin; const float* fg; const float* fb; unsigned* cnt; const LAS float* ctab;
    __device__ __forceinline__ void operator()(f32x4 (&acc)[2][2][4][2], const pg8::Unit& u, int wr, int wc, int fr, int fq, const UnitStats& st, int ui) const {
        asm volatile("" : "+v"(fr), "+v"(fq));
        const int lane = fr + 16 * fq, rowbase = u.pm * 256 + wr * 64;
        const int col0 = u.pn * 256 + wc * 32 + 4 * fq;
        bf16_t* zb = (bf16_t*)(ws + OFF_ZB);
        f32x4 gvh[2][2], bvh[2][2];
#pragma unroll
        for (int bj = 0; bj < 2; ++bj)
#pragma unroll
            for (int n = 0; n < 2; ++n) { const LAS float* ct = ctab + wc * 32 + 4 * fq + 128 * bj + 16 * n; gvh[bj][n] = *(const LAS f32x4*)ct; bvh[bj][n] = *(const LAS f32x4*)(ct + 256); }
        u32x2 zp[2][2];
        { const bf16_t* z0 = zb + (size_t)(rowbase + fr) * 1024 + col0;
#pragma unroll
          for (int bj = 0; bj < 2; ++bj)
#pragma unroll
            for (int n = 0; n < 2; ++n) zp[bj][n] = *(const u32x2*)(z0 + 128 * bj + 16 * n); }
#pragma unroll
        for (int ai = 0; ai < 2; ++ai)
#pragma unroll
            for (int m = 0; m < 4; ++m) {
                float mu, rs; st.get(ai, m, fr, mu, rs);
                const int r = rowbase + 128 * ai + 16 * m + fr;
                bf16_t* br = zb + (size_t)r * 1024 + col0;
                f32x4 zc[2][2];
#pragma unroll
                for (int bj = 0; bj < 2; ++bj)
#pragma unroll
                    for (int n = 0; n < 2; ++n) { const u32x2 q = zp[bj][n]; zc[bj][n] = (f32x4){bf2f(q.x & 0xffffu), bf2f(q.x >> 16), bf2f(q.y & 0xffffu), bf2f(q.y >> 16)}; }
                if (ai * 4 + m < 7) {
                    const int rn = rowbase + 128 * ((ai * 4 + m + 1) >> 2) + 16 * ((ai * 4 + m + 1) & 3) + fr;
                    const bf16_t* zn_ = zb + (size_t)rn * 1024 + col0;
#pragma unroll
                    for (int bj = 0; bj < 2; ++bj)
#pragma unroll
                        for (int n = 0; n < 2; ++n) zp[bj][n] = *(const u32x2*)(zn_ + 128 * bj + 16 * n);
                }
                float s = 0.f, ss = 0.f;
#pragma unroll
                for (int bj = 0; bj < 2; ++bj)
#pragma unroll
                    for (int n = 0; n < 2; ++n) {
                        f32x4 zn;
                        const f32x4 gv = gvh[bj][n], bv = bvh[bj][n];
#pragma unroll
                        for (int j = 0; j < 4; ++j) { const float h = (zc[bj][n][j] - mu) * rs * gv[j] + bv[j]; zn[j] = ALPHA * h + bscale * acc[ai][bj][m][n][j]; s += zn[j]; ss += zn[j] * zn[j]; }
                        acc[ai][bj][m][n] = zn;
                        if (!fin) {
                            u32x2 w; w.x = cvt_pk_bf16(zn[0], zn[1]); w.y = cvt_pk_bf16(zn[2], zn[3]);
                            *(u32x2*)(br + 128 * bj + 16 * n) = w;
                        }
                    }
                s += shfl_x(s, lane, 16); s += shfl_x(s, lane, 32); ss += shfl_x(ss, lane, 16); ss += shfl_x(ss, lane, 32);
                if (fq == 0) *(f32x2*)(stats_new + (size_t)r * 32 + (u.pn * 4 + wc) * 2) = (f32x2){s, ss};
            }
        if (fin) {
            asm volatile("s_waitcnt vmcnt(0)" ::: "memory");
            __builtin_amdgcn_s_barrier();
            if (wr == 0 && wc == 0 && lane == 0) {
                __builtin_amdgcn_fence(__ATOMIC_RELEASE, "agent");
                asm volatile("s_waitcnt vmcnt(0)" ::: "memory");
                __hip_atomic_fetch_add(cnt + 4 * u.pm, 1u, __ATOMIC_RELAXED, __HIP_MEMORY_SCOPE_AGENT);
                unsigned sp = 0;
                while (__hip_atomic_load(cnt + 4 * u.pm, __ATOMIC_RELAXED, __HIP_MEMORY_SCOPE_AGENT) < 4u) { __builtin_amdgcn_s_sleep(1); if (++sp > (1u << 22)) break; }
                __builtin_amdgcn_fence(__ATOMIC_ACQUIRE, "agent");
                asm volatile("s_waitcnt vmcnt(0)" ::: "memory");
            }
            __builtin_amdgcn_s_barrier();
            asm volatile("" : "+v"(fr), "+v"(fq) :: "memory");
            const int lane2 = fr + 16 * fq, colf = u.pn * 256 + wc * 32 + 4 * fq;
            UnitStats sf; sf.load(stats_new, rowbase, lane2);
            f32x4 fgv[2][2], fbv[2][2];
#pragma unroll
            for (int bj = 0; bj < 2; ++bj)
#pragma unroll
                for (int n = 0; n < 2; ++n) { const LAS float* ct = ctab + 512 + wc * 32 + 4 * fq + 128 * bj + 16 * n; fgv[bj][n] = *(const LAS f32x4*)ct; fbv[bj][n] = *(const LAS f32x4*)(ct + 256); }
#pragma unroll
            for (int ai = 0; ai < 2; ++ai)
#pragma unroll
                for (int m = 0; m < 4; ++m) {
                    float mu, rs; sf.get(ai, m, fr, mu, rs);
                    const int r = rowbase + 128 * ai + 16 * m + fr;
                    float* orow = zf + (size_t)r * 1024 + colf;
#pragma unroll
                    for (int bj = 0; bj < 2; ++bj)
#pragma unroll
                        for (int n = 0; n < 2; ++n) {
                            const f32x4 gv = fgv[bj][n], bv = fbv[bj][n];
                            f32x4 o;
#pragma unroll
                            for (int j = 0; j < 4; ++j) o[j] = (acc[ai][bj][m][n][j] - mu) * rs * gv[j] + bv[j];
                            *(f32x4*)(orow + 128 * bj + 16 * n) = o;
                        }
                    asm volatile("" ::: "memory");
                }
        }
    }
    __device__ __forceinline__ void tail(int u, int row, int c, float p0, float p1, float q0, float q1) const {
        const int r = TM + row, n0 = (u >> 2) * 256 + (u & 3) * 32 + c;
        float mu, rs; load_row_stat(stats, r, mu, rs);
        bf16_t* br = (bf16_t*)(ws + OFF_ZB) + (size_t)r * 1024;
        const float acc4[4] = {p0, p1, q0, q1}; const int cols[4] = {n0, n0 + 1, n0 + 128, n0 + 129};
        float zn[4]; float s = 0.f, ss = 0.f;
#pragma unroll
        for (int k = 0; k < 4; ++k) { const float h = (bf2f(br[cols[k]]) - mu) * rs * lg[cols[k]] + lb[cols[k]]; zn[k] = ALPHA * h + bscale * acc4[k]; s += zn[k]; ss += zn[k] * zn[k]; }
        *(unsigned*)(br + n0) = cvt_pk_bf16(zn[0], zn[1]); *(unsigned*)(br + n0 + 128) = cvt_pk_bf16(zn[2], zn[3]);
        { const int ln = lane_id_v();
#pragma unroll
        for (int o = 1; o < 16; o <<= 1) { s += shfl_x(s, ln, o); ss += shfl_x(ss, ln, o); } }
        if ((c & 30) == 0) *(f32x2*)(stats_new + (size_t)r * 32 + u * 2) = (f32x2){s, ss};
    }
};

struct EpiIn {
    static constexpr bool PERM = true;
    const float* stats; const cfix_t* c1; const cfix_t* c2; unsigned char* ws; const LAS float* ctab;
    __device__ __forceinline__ void operator()(const f32x4 (&acc)[2][2][4][2], const pg8::Unit& u, int wr, int wc, int fr, int fq, const UnitStats& st, int ui) const {
        asm volatile("" : "+v"(fr), "+v"(fq));
        const int lane = fr + 16 * fq, rowbase = u.pm * 256 + wr * 64;
        const int n0 = u.pn * 256 + wc * 32 + 8 * fq, pn = u.pn;
        f32x4 k1[2][2], k2[2][2];
#pragma unroll
        for (int bj = 0; bj < 2; ++bj)
#pragma unroll
            for (int n = 0; n < 2; ++n) { const LAS float* ct = ctab + ui * 512 + 128 * bj + wc * 32 + 8 * fq + 4 * n; k1[bj][n] = *(const LAS f32x4*)ct; k2[bj][n] = *(const LAS f32x4*)(ct + 256); }
#define VAL(ai, bj, m, n, j) (rs * (acc[ai][bj][m][n][j] - mu * k1[bj][n][j]) + k2[bj][n][j])
        if (pn == 0 || pn >= 7) {
            bf16_t* dst; int ld, col; const bool act = pn >= 9;
            if (pn == 0) { dst = (bf16_t*)(ws + OFF_XP); ld = 256; col = wc * 32 + 8 * fq; } else if (pn <= 8) { dst = (bf16_t*)(ws + OFF_V); ld = 512; col = 256 * (pn - 7) + wc * 32 + 8 * fq; } else { dst = (bf16_t*)(ws + OFF_SG); ld = 512; col = 256 * (pn - 9) + wc * 32 + 8 * fq; }
#pragma unroll
            for (int ai = 0; ai < 2; ++ai)
#pragma unroll
                for (int m = 0; m < 4; ++m) {
                    float mu, rs; st.get(ai, m, fr, mu, rs);
                    const int r = rowbase + 128 * ai + 16 * m + fr;
#pragma unroll
                    for (int bj = 0; bj < 2; ++bj) {
                        float o[8];
#pragma unroll
                        for (int n = 0; n < 2; ++n)
#pragma unroll
                            for (int j = 0; j < 4; ++j) { const float v = VAL(ai, bj, m, n, j); o[4 * n + j] = act ? silu_f(v) : v; }
                        u32x4 w; w.x = cvt_pk_bf16(o[0], o[1]); w.y = cvt_pk_bf16(o[2], o[3]); w.z = cvt_pk_bf16(o[4], o[5]); w.w = cvt_pk_bf16(o[6], o[7]);
                        *(u32x4*)(dst + (size_t)r * ld + col + 128 * bj) = w;
                    }
                }
        } else if (pn <= 2) {
            const int col = 128 * (pn - 1) + wc * 32 + 8 * fq;
            bf16_t* U = (bf16_t*)(ws + OFF_U);
#pragma unroll
            for (int ai = 0; ai < 2; ++ai)
#pragma unroll
                for (int m = 0; m < 4; ++m) {
                    float mu, rs; st.get(ai, m, fr, mu, rs);
                    const int r = rowbase + 128 * ai + 16 * m + fr;
                    float o[8];
#pragma unroll
                    for (int n = 0; n < 2; ++n)
#pragma unroll
                        for (int j = 0; j < 4; ++j) o[4 * n + j] = VAL(ai, 0, m, n, j) * fast_sigmoid(VAL(ai, 1, m, n, j));
                    u32x4 w; w.x = cvt_pk_bf16(o[0], o[1]); w.y = cvt_pk_bf16(o[2], o[3]); w.z = cvt_pk_bf16(o[4], o[5]); w.w = cvt_pk_bf16(o[6], o[7]);
                    *(u32x4*)(U + (size_t)r * 256 + col) = w;
                }
        } else {
            const bool isk = pn >= 5;
            const int head = 2 * ((pn - 3) & 1) + (wc >> 1), d0 = 32 * (wc & 1) + 8 * fq;
            bf16_t* dst = (bf16_t*)(ws + (isk ? OFF_K : OFF_Q)); bf16_t* K2 = (bf16_t*)(ws + OFF_K2);
            const float* rope = (const float*)(ws + OFF_ROPE);
            const float scale = isk ? 0.08838834764831845f : 1.0f;
            const float lgam = log2_gamma(head);
            f32x4 csn[4];
            { const f32x4* cs0 = (const f32x4*)(rope + ((size_t)(((rowbase + fr) & 8191) + NMETA) * 64 + d0) * 2);
#pragma unroll
              for (int q = 0; q < 4; ++q) csn[q] = cs0[q]; }
#pragma unroll
            for (int ai = 0; ai < 2; ++ai)
#pragma unroll
                for (int m = 0; m < 4; ++m) {
                    float mu, rs; st.get(ai, m, fr, mu, rs);
                    const int r = rowbase + 128 * ai + 16 * m + fr;
                    const int ci = r & 63;
                    f32x4 cs[4];
#pragma unroll
                    for (int q = 0; q < 4; ++q) cs[q] = csn[q];
                    if (ai * 4 + m < 7) {
                        const int rn = rowbase + 128 * ((ai * 4 + m + 1) >> 2) + 16 * ((ai * 4 + m + 1) & 3) + fr;
                        const f32x4* csp = (const f32x4*)(rope + ((size_t)((rn & 8191) + NMETA) * 64 + d0) * 2);
#pragma unroll
                        for (int q = 0; q < 4; ++q) csn[q] = csp[q];
                    }
                    const size_t off = (size_t)r * 512 + head * 128 + d0;
                    float o1[8], o2[8];
#pragma unroll
                    for (int n = 0; n < 2; ++n) {
                        const f32x4 csA = cs[2 * n], csB = cs[2 * n + 1];
                        const float cc[4] = {csA.x, csA.z, csB.x, csB.z}, sn[4] = {csA.y, csA.w, csB.y, csB.w};
#pragma unroll
                        for (int j = 0; j < 4; ++j) { const float x1 = VAL(ai, 0, m, n, j), x2 = VAL(ai, 1, m, n, j);
                            o1[4 * n + j] = (x1 * cc[j] - x2 * sn[j]) * scale; o2[4 * n + j] = (x2 * cc[j] + x1 * sn[j]) * scale; }
                    }
                    {
                        u32x4 w1, w2; w1.x = cvt_pk_bf16(o1[0], o1[1]); w1.y = cvt_pk_bf16(o1[2], o1[3]); w1.z = cvt_pk_bf16(o1[4], o1[5]); w1.w = cvt_pk_bf16(o1[6], o1[7]);
                        w2.x = cvt_pk_bf16(o2[0], o2[1]); w2.y = cvt_pk_bf16(o2[2], o2[3]); w2.z = cvt_pk_bf16(o2[4], o2[5]); w2.w = cvt_pk_bf16(o2[6], o2[7]);
                        *(u32x4*)(dst + off) = w1; *(u32x4*)(dst + off + 64) = w2;
                    }
                }
        }
#undef VAL
    }
    __device__ __forceinline__ void tail(int u, int row, int c, float p0, float p1, float q0, float q1) const {
        bf16_t *XP = (bf16_t*)(ws + OFF_XP), *U = (bf16_t*)(ws + OFF_U), *Q = (bf16_t*)(ws + OFF_Q), *K = (bf16_t*)(ws + OFF_K), *K2 = (bf16_t*)(ws + OFF_K2), *V = (bf16_t*)(ws + OFF_V), *SG = (bf16_t*)(ws + OFF_SG);
        const float* rope = (const float*)(ws + OFF_ROPE);
        const int r = TM + row, pn = u >> 2, wc = u & 3, n0 = pn * 256 + wc * 32 + c;
        float mu, rs; load_row_stat(stats, r, mu, rs);
        const float a0 = rs * (p0 - mu * cfix2f(c1[n0])) + cfix2f(c2[n0]), a1 = rs * (p1 - mu * cfix2f(c1[n0 + 1])) + cfix2f(c2[n0 + 1]);
        const float b0 = rs * (q0 - mu * cfix2f(c1[n0 + 128])) + cfix2f(c2[n0 + 128]), b1 = rs * (q1 - mu * cfix2f(c1[n0 + 129])) + cfix2f(c2[n0 + 129]);
        if (pn == 0 || pn >= 7) {
            bf16_t* dst; int ld, col; const bool act = pn >= 9;
            if (pn == 0) { dst = XP; ld = 256; col = wc * 32 + c; } else if (pn <= 8) { dst = V; ld = 512; col = 256 * (pn - 7) + wc * 32 + c; } else { dst = SG; ld = 512; col = 256 * (pn - 9) + wc * 32 + c; }
            *(unsigned*)(dst + (size_t)r * ld + col) = act ? cvt_pk_bf16(silu_f(a0), silu_f(a1)) : cvt_pk_bf16(a0, a1);
            *(unsigned*)(dst + (size_t)r * ld + col + 128) = act ? cvt_pk_bf16(silu_f(b0), silu_f(b1)) : cvt_pk_bf16(b0, b1);
        } else if (pn <= 2) {
            *(unsigned*)(U + (size_t)r * 256 + 128 * (pn - 1) + wc * 32 + c) = cvt_pk_bf16(a0 * fast_sigmoid(b0), a1 * fast_sigmoid(b1));
        } else {
            const bool isk = pn >= 5;
            const int head = 2 * ((pn - 3) & 1) + (wc >> 1), d = 32 * (wc & 1) + c, t = row & 15, ci = 48 + t;
            const float scale = isk ? 0.08838834764831845f : 1.0f;
            const f32x4 cs = *(const f32x4*)(rope + ((size_t)t * 64 + d) * 2);
            const float o10 = (a0 * cs.x - b0 * cs.y) * scale, o20 = (b0 * cs.x + a0 * cs.y) * scale;
            const float o11 = (a1 * cs.z - b1 * cs.w) * scale, o21 = (b1 * cs.z + a1 * cs.w) * scale;
            bf16_t* dst = isk ? K : Q; const size_t off = (size_t)r * 512 + head * 128 + d;
            *(unsigned*)(dst + off) = cvt_pk_bf16(o10, o11); *(unsigned*)(dst + off + 64) = cvt_pk_bf16(o20, o21);
        }
    }
};

template <class Epi>
__device__ __forceinline__ void tail_units(unsigned char* smem, const bf16_t* At, const bf16_t* Bt, int K, int nunits, int c0, const Epi& E, const int tid, const int bid) {
    const int wid = tid >> 6, lane = tid & 63; constexpr int G = GRID;
    float* part = (float*)smem;
    const int kw = K / 8;
    for (int u = (bid - c0 + G) % G; u < nunits; u += G) {
        const int n0 = (u >> 2) * 256 + (u & 3) * 32;
        f32x16 acc0, acc1;
#pragma unroll
        for (int i = 0; i < 16; ++i) { acc0[i] = 0.f; acc1[i] = 0.f; }
        const bf16_t* ap = At + (size_t)(lane & 31) * K + wid * kw + 8 * (lane >> 5);
        const bf16_t* bp0 = Bt + (size_t)(n0 + (lane & 31)) * K + wid * kw + 8 * (lane >> 5);
        const bf16_t* bp1 = bp0 + (size_t)128 * K;
        for (int k0 = 0; k0 < kw; k0 += 64) {
            bf16x8 av[4], b0v[4], b1v[4];
#pragma unroll
            for (int j = 0; j < 4; ++j) if (k0 + 16 * j < kw) { av[j] = *(const bf16x8*)(ap + k0 + 16 * j); b0v[j] = *(const bf16x8*)(bp0 + k0 + 16 * j); b1v[j] = *(const bf16x8*)(bp1 + k0 + 16 * j); }
#pragma unroll
            for (int j = 0; j < 4; ++j) if (k0 + 16 * j < kw) {
                acc0 = __builtin_amdgcn_mfma_f32_32x32x16_bf16(av[j], b0v[j], acc0, 0, 0, 0);
                acc1 = __builtin_amdgcn_mfma_f32_32x32x16_bf16(av[j], b1v[j], acc1, 0, 0, 0);
            }
        }
#pragma unroll
        for (int i = 0; i < 16; ++i) { const int row = (i & 3) + 8 * (i >> 2) + 4 * (lane >> 5); part[wid * 2048 + row * 64 + (lane & 31)] = acc0[i]; part[wid * 2048 + row * 64 + 32 + (lane & 31)] = acc1[i]; }
        __syncthreads();
        const int row = tid >> 4, c = (tid & 15) * 2;
        float p0 = 0.f, p1 = 0.f, q0 = 0.f, q1 = 0.f;
#pragma unroll
        for (int w = 0; w < 8; ++w) { const float* pp = part + w * 2048 + row * 64 + c; p0 += pp[0]; p1 += pp[1]; q0 += pp[32]; q1 += pp[33]; }
        E.tail(u, row, c, p0, p1, q0, q1);
        __syncthreads();
    }
}


__device__ __forceinline__ bf16x8 tr_frag(const unsigned char* tile, int stride, int row0, int col0, int lane) {
    const int g = lane >> 4, q = (lane & 15) >> 2, p = lane & 3;
    const unsigned char* a0 = tile + (row0 + 4 * g + q) * stride + (col0 + 4 * p) * 2;
    const v4i16_t lo = __builtin_amdgcn_ds_read_tr16_b64_v4i16((LAS v4i16_t*)(a0));
    const v4i16_t hi = __builtin_amdgcn_ds_read_tr16_b64_v4i16((LAS v4i16_t*)(a0 + 16 * stride));
    bf16x8 r; r[0] = lo[0]; r[1] = lo[1]; r[2] = lo[2]; r[3] = lo[3]; r[4] = hi[0]; r[5] = hi[1]; r[6] = hi[2]; r[7] = hi[3];
    return r;
}
template <int NKS>
__device__ __forceinline__ void tile_gemm_loadB(bf16x8 (&bf)[NKS][2], const bf16_t* Bt, int ks_lo, int wave, int lane) {
    const bf16_t* bp = Bt + (size_t)(32 * wave + (lane & 15)) * 256 + 8 * (lane >> 4) + 32 * ks_lo;
#pragma unroll
    for (int ks = 0; ks < NKS; ++ks) { bf[ks][0] = *(const bf16x8*)(bp + 32 * ks); bf[ks][1] = *(const bf16x8*)(bp + 16 * 256 + 32 * ks); }
}
template <int NKS>
__device__ __forceinline__ void tile_gemm64(const unsigned char* At, int ast, const bf16x8 (&bf)[NKS][2], int ks_lo, int lane, f32x4 (&acc)[4][2]) {
#pragma unroll
    for (int mt = 0; mt < 4; ++mt) { acc[mt][0] = (f32x4){0.f, 0.f, 0.f, 0.f}; acc[mt][1] = (f32x4){0.f, 0.f, 0.f, 0.f}; }
    const unsigned char* ap = At + (lane & 15) * ast + 16 * (lane >> 4) + 64 * ks_lo;
#pragma unroll
    for (int ks = 0; ks < NKS; ++ks) {
#pragma unroll
        for (int mt = 0; mt < 4; ++mt) {
            const bf16x8 av = *(const bf16x8*)(ap + 16 * mt * ast + 64 * ks);
            acc[mt][0] = __builtin_amdgcn_mfma_f32_16x16x32_bf16(bf[ks][0], av, acc[mt][0], 0, 0, 0);
            acc[mt][1] = __builtin_amdgcn_mfma_f32_16x16x32_bf16(bf[ks][1], av, acc[mt][1], 0, 0, 0);
        }
    }
}
__device__ __forceinline__ void load_tok_tile(unsigned char* tile, const bf16_t* src, int b, int t0, int halo, int tid) {
    const int nchunk = (64 + halo) * 32;
    u32x4 v[6];
#pragma unroll
    for (int k = 0; k < 6; ++k) {
        const int idx = tid + 512 * k, row = idx >> 5, ch = idx & 31, t = t0 - halo + row;
        const bool ok = idx < nchunk && t >= 0 && t < LSEQ;
        const u32x4 ld = *(const u32x4*)(src + (size_t)tok_row(b, ok ? t : 0) * 256 + ch * 8);
        v[k] = ok ? ld : (u32x4){0u, 0u, 0u, 0u};
    }
#pragma unroll
    for (int k = 0; k < 6; ++k) { const int idx = tid + 512 * k, row = idx >> 5, ch = idx & 31; if (idx < nchunk) *(u32x4*)(tile + row * 512 + ch * 16) = v[k]; }
}
constexpr int ATS = 528;
constexpr int YS = 260;
constexpr int KTS = 272;
constexpr int LDS_AT = 49152, LDS_Y = 49152;

__device__ __forceinline__ void store_tile64(const f32x4 (&acc)[4][2], bf16_t* YC, int colbase, int b, int t0, int wave, int lane) {
#pragma unroll
    for (int mt = 0; mt < 4; ++mt) {
        const int t = t0 + 16 * mt + (lane & 15);
        if (t < LSEQ) {
            bf16_t* dst = YC + (size_t)tok_row(b, t) * 1024 + colbase + 32 * wave + 4 * (lane >> 4);
#pragma unroll
            for (int nt = 0; nt < 2; ++nt) { u32x2 w; w.x = cvt_pk_bf16(acc[mt][nt][0], acc[mt][nt][1]); w.y = cvt_pk_bf16(acc[mt][nt][2], acc[mt][nt][3]); *(u32x2*)(dst + 16 * nt) = w; }
        }
    }
}

__device__ __forceinline__ void pool_item(unsigned char* smem, const bf16_t* XP, const bf16_t* PPT, bf16_t* YC, int b, int tb, int tid) {
    const int t0 = 64 * tb, lane = tid & 63, wave = tid >> 6;
    load_tok_tile(smem, XP, b, t0, 15, tid);
    bf16x8 bfr[2][2]; tile_gemm_loadB<2>(bfr, PPT, 2 * (wave >> 1), wave, lane);
    __syncthreads();
    {
        const int c = tid & 255, i0 = (tid >> 8) * 32, gi = c >> 6, w = 2 << gi;
        const bf16_t* xt = (const bf16_t*)smem;
        float s = 0.f;
#pragma unroll 1
        for (int k = 1; k < w; ++k) s += bf2f(xt[(i0 + 15 - k) * 256 + c]);
        bf16_t* at = (bf16_t*)(smem + LDS_AT);
#pragma unroll 1
        for (int ib = i0; ib < i0 + 32; ib += 8) {
            unsigned short xa[8], xo[8];
#pragma unroll
            for (int q = 0; q < 8; ++q) { xa[q] = xt[(ib + q + 15) * 256 + c]; xo[q] = xt[(ib + q + 15 - (w - 1)) * 256 + c]; }
#pragma unroll
            for (int q = 0; q < 8; ++q) {
                const float xv = bf2f(xa[q]);
                s += xv;
                const int t = t0 + ib + q, cnt = (t + 1 < w) ? (t + 1) : w;
                at[(ib + q) * (ATS / 2) + c] = (bf16_t)f2bf(s * __builtin_amdgcn_rcpf((float)cnt) - xv);
                s -= bf2f(xo[q]);
            }
        }
    }
    __syncthreads();
    f32x4 acc[4][2];
    tile_gemm64<2>(smem + LDS_AT, ATS, bfr, 2 * (wave >> 1), lane, acc);
    store_tile64(acc, YC, 0, b, t0, wave, lane);
    __syncthreads();
}

__device__ __forceinline__ void conv_item(unsigned char* smem, const bf16_t* U, const bf16_t* PWT, const float* dw, const float* db, const float* lng, const float* lnb, bf16_t* YC, int b, int tb, int tid) {
    const int t0 = 64 * tb, lane = tid & 63, wave = tid >> 6;
    float w[31];
    {
        const int c = tid & 255;
#pragma unroll
        for (int j = 0; j < 31; ++j) w[j] = dw[j * 256 + c];
    }
    const float bias = db[tid & 255];
    load_tok_tile(smem, U, b, t0, 30, tid);
    __syncthreads();
    {
        const int c = tid & 255, i0 = (tid >> 8) * 32;
        const bf16_t* ut = (const bf16_t*)smem;
        float* Y = (float*)(smem + LDS_Y);
#pragma unroll 1
        for (int grp = 0; grp < 4; ++grp) {
            float a8[8];
#pragma unroll
            for (int i = 0; i < 8; ++i) a8[i] = bias;
            const bf16_t* up = ut + (i0 + grp * 8) * 256 + c;
#pragma unroll
            for (int jb = 0; jb < 40; jb += 8) {
                unsigned short raw[8];
#pragma unroll
                for (int q = 0; q < 8; ++q) raw[q] = (jb + q < 38) ? up[(jb + q) * 256] : (unsigned short)0;
#pragma unroll
                for (int q = 0; q < 8; ++q) {
                    const int jj = jb + q; const float v = bf2f(raw[q]);
#pragma unroll
                    for (int i = 0; i < 8; ++i) if (jj < 38 && jj - i >= 0 && jj - i <= 30) a8[i] += w[jj - i] * v;
                }
            }
#pragma unroll
            for (int i = 0; i < 8; ++i) Y[(i0 + grp * 8 + i) * YS + c] = a8[i];
        }
    }
    __syncthreads();
    bf16x8 bfr[8][2]; tile_gemm_loadB<8>(bfr, PWT, 0, wave, lane);
    {
        const float* Y = (const float*)(smem + LDS_Y);
        const f32x4 gg = *(const f32x4*)(lng + 4 * lane), bb = *(const f32x4*)(lnb + 4 * lane);
#pragma unroll 2
        for (int k = 0; k < 8; ++k) {
            const int tok = 8 * wave + k;
            f32x4 y = *(const f32x4*)(Y + tok * YS + 4 * lane);
            float s1 = (y.x + y.y) + (y.z + y.w), s2 = (y.x * y.x + y.y * y.y) + (y.z * y.z + y.w * y.w);
#pragma unroll
            for (int o = 1; o < 64; o <<= 1) { s1 += shfl_x(s1, lane, o); s2 += shfl_x(s2, lane, o); }
            const float mean = s1 * (1.f / 256.f);
            const float rstd = rsqrtf(fmaxf(s2 * (1.f / 256.f) - mean * mean, 0.f) + LN_EPS);
            y = y - mean;
            const f32x4 n = y * rstd * gg + bb;
            u32x2 pk; pk.x = cvt_pk_bf16(silu_f(n.x), silu_f(n.y)); pk.y = cvt_pk_bf16(silu_f(n.z), silu_f(n.w));
            *(u32x2*)(smem + tok * ATS + 8 * lane) = pk;
        }
    }
    __syncthreads();
    f32x4 acc[4][2];
    tile_gemm64<8>(smem, ATS, bfr, 0, lane, acc);
    store_tile64(acc, YC, 256, b, t0, wave, lane);
    __syncthreads();
}

__device__ __forceinline__ int chunk_row(int b, int n, int p) { return n == 0 ? (p >= 48 ? TM + 16 * b + p - 48 : -1) : SEQ * b + 64 * (n - 1) + p; }
__device__ __forceinline__ void chunk_tile_load(u32x4 (&v)[2], const bf16_t* src, int b, int n, int h, int tid) {
#pragma unroll
    for (int k = 0; k < 2; ++k) {
        const int idx = tid + 512 * k, p = idx >> 4, ch = idx & 15, row = chunk_row(b, n, p);
        const u32x4 ld = *(const u32x4*)(src + (size_t)(row >= 0 ? row : 0) * 512 + h * 128 + ch * 8);
        v[k] = row >= 0 ? ld : (u32x4){0u, 0u, 0u, 0u};
    }
}
__device__ __forceinline__ void chunk_tile_store(unsigned char* tile, const u32x4 (&v)[2], int tid) {
#pragma unroll
    for (int k = 0; k < 2; ++k) { const int idx = tid + 512 * k, p = idx >> 4, ch = idx & 15; *(u32x4*)(tile + p * KTS + ch * 16) = v[k]; }
}
template <int NP>
__device__ __forceinline__ void kv_item(unsigned char* smem, const bf16_t* K2, const bf16_t* V, bf16_t* ST, int bh, int n, int tid) {
    const int lane = tid & 63, wave = tid >> 6, b = bh >> 2, h = bh & 3;
    {
        u32x4 vk[NP][2], vv[NP][2];
#pragma unroll
        for (int c = 0; c < NP; ++c) { chunk_tile_load(vk[c], K2, b, n + c, h, tid); chunk_tile_load(vv[c], V, b, n + c, h, tid); }
        {
            const float lgam = log2_gamma(h);
#pragma unroll
            for (int c = 0; c < NP; ++c)
#pragma unroll
                for (int k2 = 0; k2 < 2; ++k2) {
                    const float dec = __builtin_amdgcn_exp2f(lgam * (float)(63 - ((tid + 512 * k2) >> 4)));
                    u32x4 q = vk[c][k2];
                    q.x = cvt_pk_bf16(bf2f(q.x & 0xffffu) * dec, bf2f(q.x >> 16) * dec); q.y = cvt_pk_bf16(bf2f(q.y & 0xffffu) * dec, bf2f(q.y >> 16) * dec);
                    q.z = cvt_pk_bf16(bf2f(q.z & 0xffffu) * dec, bf2f(q.z >> 16) * dec); q.w = cvt_pk_bf16(bf2f(q.w & 0xffffu) * dec, bf2f(q.w >> 16) * dec);
                    vk[c][k2] = q;
                }
        }
#pragma unroll
        for (int c = 0; c < NP; ++c) { chunk_tile_store(smem + c * 128 * KTS, vk[c], tid); chunk_tile_store(smem + c * 128 * KTS + 64 * KTS, vv[c], tid); }
    }
    __syncthreads();
    const int dt0 = 2 * (wave & 3), et0 = 4 * (wave >> 2);
#pragma unroll
    for (int c = 0; c < NP; ++c) {
        const unsigned char* kt = smem + c * 128 * KTS;
        f32x4 acc[2][4];
#pragma unroll
        for (int dt = 0; dt < 2; ++dt)
#pragma unroll
            for (int et = 0; et < 4; ++et) acc[dt][et] = (f32x4){0.f, 0.f, 0.f, 0.f};
#pragma unroll
        for (int ks = 0; ks < 2; ++ks) {
            bf16x8 af[2], bfr[4];
#pragma unroll
            for (int dt = 0; dt < 2; ++dt) af[dt] = tr_frag(kt, KTS, 32 * ks, 16 * (dt0 + dt), lane);
#pragma unroll
            for (int et = 0; et < 4; ++et) bfr[et] = tr_frag(kt + 64 * KTS, KTS, 32 * ks, 16 * (et0 + et), lane);
#pragma unroll
            for (int dt = 0; dt < 2; ++dt)
#pragma unroll
                for (int et = 0; et < 4; ++et) acc[dt][et] = __builtin_amdgcn_mfma_f32_16x16x32_bf16(af[dt], bfr[et], acc[dt][et], 0, 0, 0);
        }
        bf16_t* dst = ST + ((size_t)(bh * NCHUNK + n + c)) * 16384;
#pragma unroll
        for (int dt = 0; dt < 2; ++dt)
#pragma unroll
            for (int et = 0; et < 4; ++et) { u32x2 w; w.x = cvt_pk_bf16(acc[dt][et][0], acc[dt][et][1]); w.y = cvt_pk_bf16(acc[dt][et][2], acc[dt][et][3]);
                *(u32x2*)(dst + (16 * (et0 + et) + (lane & 15)) * 128 + 16 * (dt0 + dt) + 4 * (lane >> 4)) = w; }
    }
    __syncthreads();
}

struct RetRegs { u32x4 vk[2], vv[2], vs[4]; bf16x8 qf[4]; u32x4 sg[2]; };
__device__ __forceinline__ void ret_load(RetRegs& R, const bf16_t* Q, const bf16_t* Kb, const bf16_t* V, const bf16_t* ST, const bf16_t* SG, int bh, int n, int tid) {
    const int lane = tid & 63, wave = tid >> 6, b = bh >> 2, h = bh & 3, g = lane >> 4, li = lane & 15, it = wave & 3, eh = wave >> 2;
    chunk_tile_load(R.vk, Kb, b, n, h, tid); chunk_tile_load(R.vv, V, b, n, h, tid);
    const bf16_t* sp = ST + ((size_t)(bh * NCHUNK + n)) * 16384;
#pragma unroll
    for (int k = 0; k < 4; ++k) { const int idx = tid + 512 * k, e = idx >> 4, ch = idx & 15; R.vs[k] = *(const u32x4*)(sp + e * 128 + ch * 8); }
    const int qrow = chunk_row(b, n, 16 * it + li);
#pragma unroll
    for (int ks = 0; ks < 4; ++ks) { const bf16x8 ld = *(const bf16x8*)(Q + (size_t)(qrow >= 0 ? qrow : 0) * 512 + h * 128 + 32 * ks + 8 * g); R.qf[ks] = qrow >= 0 ? ld : (bf16x8){0, 0, 0, 0, 0, 0, 0, 0}; }
#pragma unroll
    for (int k = 0; k < 2; ++k) {
        const int idx = tid + 512 * k, p = idx >> 4, ch = idx & 15, row = chunk_row(b, n, p);
        const u32x4 ld = *(const u32x4*)(SG + (size_t)(row >= 0 ? row : 0) * 512 + h * 128 + ch * 8);
        R.sg[k] = row >= 0 ? ld : (u32x4){0u, 0u, 0u, 0u};
    }
}
__device__ __forceinline__ void ret_item(unsigned char* smem, RetRegs& R, const bf16_t* Q, const bf16_t* Kb, const bf16_t* V, const bf16_t* ST, const bf16_t* SG, const float* gng, bf16_t* YC, int bh, int n, bool has_next, int nbh, int nn, int tid) {
    const int lane = tid & 63, wave = tid >> 6, b = bh >> 2, h = bh & 3, g = lane >> 4, li = lane & 15;
    unsigned char* KT = smem; unsigned char* VT = smem + 64 * KTS; unsigned char* STt = smem + 128 * KTS; float* PS = (float*)(smem + 256 * KTS);
    const int it = wave & 3, eh = wave >> 2;
    chunk_tile_store(KT, R.vk, tid); chunk_tile_store(VT, R.vv, tid);
#pragma unroll
    for (int k = 0; k < 4; ++k) { const int idx = tid + 512 * k, e = idx >> 4, ch = idx & 15; *(u32x4*)(STt + e * KTS + ch * 16) = R.vs[k]; }
    bf16x8 qf[4]; u32x4 sgc[2];
#pragma unroll
    for (int ks = 0; ks < 4; ++ks) qf[ks] = R.qf[ks];
    sgc[0] = R.sg[0]; sgc[1] = R.sg[1];
    __syncthreads();
    if (has_next) ret_load(R, Q, Kb, V, ST, SG, nbh, nn, tid);
    const float lgam = log2_gamma(h);
    float ggv[4];
#pragma unroll
    for (int et = 0; et < 4; ++et) ggv[et] = gng[h * 128 + 64 * eh + 16 * et + li];
    bf16x8 pf[2];
#pragma unroll
    for (int jt = 0; jt < 4; ++jt) {
        f32x4 sacc = (f32x4){0.f, 0.f, 0.f, 0.f};
#pragma unroll
        for (int ks = 0; ks < 4; ++ks) { const bf16x8 kf = *(const bf16x8*)(KT + (16 * jt + li) * KTS + 64 * ks + 16 * g); sacc = __builtin_amdgcn_mfma_f32_16x16x32_bf16(kf, qf[ks], sacc, 0, 0, 0); }
        const int i = 16 * it + li;
#pragma unroll
        for (int r = 0; r < 4; ++r) { const int j = 16 * jt + 4 * g + r, dist = i > j ? i - j : j - i; sacc[r] *= __builtin_amdgcn_exp2f(lgam * (float)dist); }
        const unsigned lo = cvt_pk_bf16(sacc[0], sacc[1]), hi = cvt_pk_bf16(sacc[2], sacc[3]);
        const int base = 4 * (jt & 1);
        pf[jt >> 1][base + 0] = (short)(lo & 0xffffu); pf[jt >> 1][base + 1] = (short)(lo >> 16); pf[jt >> 1][base + 2] = (short)(hi & 0xffffu); pf[jt >> 1][base + 3] = (short)(hi >> 16);
    }
    f32x4 o[4];
#pragma unroll
    for (int et = 0; et < 4; ++et) {
        const int e0 = 64 * eh + 16 * et;
        f32x4 a = (f32x4){0.f, 0.f, 0.f, 0.f};
#pragma unroll
        for (int ks = 0; ks < 4; ++ks) { const bf16x8 sf = *(const bf16x8*)(STt + (e0 + li) * KTS + 64 * ks + 16 * g); a = __builtin_amdgcn_mfma_f32_16x16x32_bf16(qf[ks], sf, a, 0, 0, 0); }
#pragma unroll
        for (int r = 0; r < 4; ++r) a[r] *= __builtin_amdgcn_exp2f(lgam * (float)(16 * it + 4 * g + r + 1));
#pragma unroll
        for (int ks = 0; ks < 2; ++ks) { const bf16x8 vf = tr_frag(VT, KTS, 32 * ks, e0, lane); a = __builtin_amdgcn_mfma_f32_16x16x32_bf16(pf[ks], vf, a, 0, 0, 0); }
        o[et] = a;
    }
    float ps[4], pss[4];
#pragma unroll
    for (int r = 0; r < 4; ++r) { float s1 = 0.f, s2 = 0.f;
#pragma unroll
        for (int et = 0; et < 4; ++et) { s1 += o[et][r]; s2 += o[et][r] * o[et][r]; }
#pragma unroll
        for (int m = 1; m < 16; m <<= 1) { s1 += shfl_x(s1, lane, m); s2 += shfl_x(s2, lane, m); }
        ps[r] = s1; pss[r] = s2; }
    if (li == 0) {
#pragma unroll
        for (int r = 0; r < 4; ++r) *(f32x2*)(PS + (eh * 64 + 16 * it + 4 * g + r) * 2) = (f32x2){ps[r], pss[r]};
    }
    __syncthreads();
#pragma unroll
    for (int r = 0; r < 4; ++r) {
        const int p = 16 * it + 4 * g + r, row = chunk_row(b, n, p);
        const f32x2 oth = *(const f32x2*)(PS + ((eh ^ 1) * 64 + p) * 2);
        const float mean = (ps[r] + oth.x) * (1.f / 128.f);
        const float var = (pss[r] + oth.y) * (1.f / 128.f) - mean * mean;
        const float rstd = rsqrtf(fmaxf(var, 0.f) + LN_EPS);
        {
#pragma unroll
            for (int et = 0; et < 4; ++et) ((bf16_t*)KT)[p * (KTS / 2) + 64 * eh + 16 * et + li] = (bf16_t)f2bf((o[et][r] - mean) * rstd * ggv[et]);
        }
    }
    __syncthreads();
#pragma unroll
    for (int k = 0; k < 2; ++k) {
        const int idx = tid + 512 * k, p = idx >> 4, ch = idx & 15, row = chunk_row(b, n, p);
        const u32x4 y = *(const u32x4*)(KT + p * KTS + ch * 16), q = sgc[k];
        u32x4 w;
        w.x = cvt_pk_bf16(bf2f(y.x & 0xffffu) * bf2f(q.x & 0xffffu), bf2f(y.x >> 16) * bf2f(q.x >> 16));
        w.y = cvt_pk_bf16(bf2f(y.y & 0xffffu) * bf2f(q.y & 0xffffu), bf2f(y.y >> 16) * bf2f(q.y >> 16));
        w.z = cvt_pk_bf16(bf2f(y.z & 0xffffu) * bf2f(q.z & 0xffffu), bf2f(y.z >> 16) * bf2f(q.z >> 16));
        w.w = cvt_pk_bf16(bf2f(y.w & 0xffffu) * bf2f(q.w & 0xffffu), bf2f(y.w >> 16) * bf2f(q.w >> 16));
        if (row >= 0) *(u32x4*)(YC + (size_t)row * 1024 + 512 + h * 128 + ch * 8) = w;
    }
    __syncthreads();
}

#define XB_TMO      128
#define XB_XCNT(j)  (256  + 64 * (j))
#define XB_XSUB(j)  (1280 + 64 * (j))
#define XB_XGEN(j)  (2304 + 64 * (j))
#define XB_TOP      3328
#define XB_TOPGEN   3392
#define XCD_BAR_WORDS 3456
#define XB_SPIN_CAP (1u << 22)
__device__ __forceinline__ unsigned xb_ld(unsigned* p)              { return __hip_atomic_load(p, __ATOMIC_RELAXED, __HIP_MEMORY_SCOPE_AGENT); }
__device__ __forceinline__ unsigned xb_add(unsigned* p, unsigned v) { return __hip_atomic_fetch_add(p, v, __ATOMIC_RELAXED, __HIP_MEMORY_SCOPE_AGENT); }
__device__ __forceinline__ unsigned xb_xcc_id() { return (unsigned)__builtin_amdgcn_s_getreg((3 << 11) | 20) & 0xFu; }
#define XB_SPIN(cond, bar) do { unsigned _sp = 0; while (cond) { __builtin_amdgcn_s_sleep(1); \
    if ((++_sp & 255u) == 0u) { if (xb_ld(&(bar)[XB_TMO])) break; if (_sp > XB_SPIN_CAP) { atomicAdd(&(bar)[XB_TMO], 1u); break; } } } } while (0)
struct XcdBarrier { unsigned* bar; unsigned x; volatile LAS unsigned* st; };
__device__ __forceinline__ XcdBarrier xcd_barrier_post(unsigned* bar, volatile LAS unsigned* st) {
    XcdBarrier b; b.bar = bar; b.x = xb_xcc_id(); b.st = st;
    if (threadIdx.x == 0) (void)xb_add(&bar[XB_XCNT(b.x)], 1u);
    return b;
}
__device__ __forceinline__ void xcd_barrier_complete(unsigned* bar, unsigned x, unsigned& nloc, unsigned& nx) {
    const unsigned G = gridDim.x * gridDim.y * gridDim.z;
    unsigned sum, cnt, mine, sp = 0u;
    for (;;) {
        sum = 0u; cnt = 0u; mine = 0u;
#pragma unroll
        for (unsigned j = 0; j < 16; ++j) { const unsigned c = xb_ld(&bar[XB_XCNT(j)]); sum += c; cnt += (c > 0u) ? 1u : 0u; mine = (j == x) ? c : mine; }
        if (sum == G) break;
        __builtin_amdgcn_s_sleep(1);
        if ((++sp & 255u) == 0u) { if (xb_ld(&bar[XB_TMO])) break; if (sp > XB_SPIN_CAP) { atomicAdd(&bar[XB_TMO], 1u); break; } }
    }
    nloc = mine > 0u ? mine : 1u; nx = cnt > 0u ? cnt : 1u;
}
__device__ __forceinline__ void xcd_barrier(const XcdBarrier& b, const int wave_s) {
    asm volatile("s_waitcnt vmcnt(0)" ::: "memory");
    __syncthreads();
    if (wave_s == 0 && lane_id_v() == 0) {
        unsigned* bar = b.bar;
        asm volatile("" : "+s"(bar));
        __builtin_amdgcn_s_waitcnt(0);
        unsigned nloc = b.st[0], nx = b.st[1];
        if (nloc == 0u) { xcd_barrier_complete(bar, b.x, nloc, nx); b.st[0] = nloc; b.st[1] = nx; }
        const unsigned old = xb_add(&bar[XB_XSUB(b.x)], 1u);
        const unsigned gen = old / nloc;
        if (old + 1u == (gen + 1u) * nloc) {
            __builtin_amdgcn_fence(__ATOMIC_RELEASE, "agent");
            asm volatile("s_waitcnt vmcnt(0)" ::: "memory");
            const unsigned og = xb_add(&bar[XB_TOP], 1u);
            const unsigned tg = og / nx;
            if (og + 1u == (tg + 1u) * nx) xb_add(&bar[XB_TOPGEN], 1u);
            else XB_SPIN(xb_ld(&bar[XB_TOPGEN]) == tg, bar);
            __builtin_amdgcn_fence(__ATOMIC_ACQUIRE, "agent");
            xb_add(&bar[XB_XGEN(b.x)], 1u);
            asm volatile("s_waitcnt vmcnt(0)" ::: "memory");
        } else {
            XB_SPIN(xb_ld(&bar[XB_XGEN(b.x)]) == gen, bar);
            __builtin_amdgcn_fence(__ATOMIC_ACQUIRE, "agent");
            asm volatile("s_waitcnt vmcnt(0)" ::: "memory");
        }
    }
    __syncthreads();
}

__device__ __forceinline__ void cvt_item(const float* src, int K, int Nsrc, bf16_t* dst, int Kp, int Nd, int type, const float* g, const float* b, cfix_t* c1, cfix_t* c2, int item, float* scr, int lane) {
    const int nblk = Nd / 32, kb = item / nblk, nb = item % nblk, k0 = 64 * kb, n0 = 32 * nb;
    int sc = n0; bool valid = true;
    const int pn = n0 >> 8, bj = (n0 >> 7) & 1, cc = n0 & 127;
    if (type == 0) { const int gcol = 128 * pn + cc; valid = gcol < DFF; sc = bj ? DFF + gcol : gcol; }
    else if (type == 2) {
        if (pn == 0 || pn >= 7) sc = n0;
        else if (pn <= 2) sc = 256 + 256 * bj + 128 * (pn - 1) + cc;
        else { const int base = pn <= 4 ? 768 : 1280, head = 2 * ((pn - 3) & 1) + (cc >> 6); sc = base + 128 * head + 64 * bj + (cc & 63); }
    }
    float a1 = 0.f, a2 = 0.f;
    float vv[32];
#pragma unroll
    for (int i = 0; i < 32; ++i) { const int k = k0 + 2 * i + (lane >> 5); vv[i] = (valid && k < K) ? src[(size_t)k * Nsrc + sc + (lane & 31)] : 0.f; }
#pragma unroll
    for (int i = 0; i < 32; ++i) {
        const int kk = 2 * i + (lane >> 5), k = k0 + kk;
        float v = vv[i];
        if (g) { a2 += b[k] * v; v *= g[k]; a1 += bf2f(f2bf(v)); }
        scr[kk * 33 + (lane & 31)] = v;
    }
    if (g) { a1 += shfl_x(a1, lane, 32); a2 += shfl_x(a2, lane, 32); if (lane < 32) { atomicAdd((unsigned long long*)(c1 + n0 + lane), (unsigned long long)(cfix_t)llrintf(a1 * 4294967296.0f)); atomicAdd((unsigned long long*)(c2 + n0 + lane), (unsigned long long)(cfix_t)llrintf(a2 * 4294967296.0f)); } }
    asm volatile("s_waitcnt lgkmcnt(0)" ::: "memory");
    const int c = lane & 7;
#pragma unroll
    for (int j = 0; j < 4; ++j) { const int n = (lane >> 3) + 8 * j; const float* s = scr + (8 * c) * 33 + n;
        u32x4 o; o.x = cvt_pk_bf16(s[0 * 33], s[1 * 33]); o.y = cvt_pk_bf16(s[2 * 33], s[3 * 33]); o.z = cvt_pk_bf16(s[4 * 33], s[5 * 33]); o.w = cvt_pk_bf16(s[6 * 33], s[7 * 33]);
        *(u32x4*)(dst + (size_t)(n0 + n) * Kp + k0 + 8 * c) = o; }
    asm volatile("s_waitcnt lgkmcnt(0)" ::: "memory");
}
__device__ __forceinline__ void cvt_job(const float* src, int K, int Nsrc, bf16_t* dst, int Kp, int Nd, int type, const float* g, const float* b, cfix_t* c1, cfix_t* c2, float* scr, int gw, int NGW, int lane) {
    const int nitems = (Kp / 64) * (Nd / 32);
    for (int it = gw; it < nitems; it += NGW) cvt_item(src, K, Nsrc, dst, Kp, Nd, type, g, b, c1, c2, it, scr, lane);
}

struct Args { const float* in[20]; float* out; unsigned char* ws; int ph_lo, ph_hi, use_cg, pad; };

#define INP(i) ((const float*)(((unsigned long long)(unsigned)__builtin_amdgcn_readfirstlane((int)ptab[2 * (i) + 1]) << 32) | (unsigned long long)(unsigned)__builtin_amdgcn_readfirstlane((int)ptab[2 * (i)])))
template <bool PRO, bool MID, int MASK>
__device__ __forceinline__ void run_phase(const Args& a, unsigned char* smem, volatile LAS unsigned* ptab_in, const int ph, const int G, const int NGW, const int NTH, const int wave_s) {
        unsigned pt_ = (unsigned)(unsigned long long)ptab_in; asm volatile("" : "+s"(pt_));
        volatile LAS unsigned* ptab = (volatile LAS unsigned*)(unsigned long long)pt_;
        unsigned char* ws = a.ws; float* zf = a.out;
        asm volatile("" : "+s"(ws), "+s"(zf));
        int bid = blockIdx.x;
        asm volatile("" : "+s"(bid));
        const int wave = wave_s;
#define TID_SETUP int tid = wave_s * 64 + lane_id_v(); const int lane = tid & 63, gw = bid * 8 + wave, gtid = bid * 512 + tid; (void)lane; (void)gw; (void)gtid;
        const float* x = INP(0); const float* meta = INP(1);
        float* zfm = (float*)(ws + OFF_ZFM);
        float* stats0 = (float*)(ws + OFF_STATS); float* stats1 = (float*)(ws + OFF_STATS + STATS_BYTES);
        float* rope = (float*)(ws + OFF_ROPE);
        cfix_t* cvec = (cfix_t*)(ws + OFF_CVEC);
        bf16_t* zb = (bf16_t*)(ws + OFF_ZB);
        bf16_t* Gb = (bf16_t*)(ws + OFF_G);
        bf16_t *XP = (bf16_t*)(ws + OFF_XP), *U = (bf16_t*)(ws + OFF_U), *Q = (bf16_t*)(ws + OFF_Q), *Kb = (bf16_t*)(ws + OFF_K), *K2 = (bf16_t*)(ws + OFF_K2), *V = (bf16_t*)(ws + OFF_V), *SG = (bf16_t*)(ws + OFF_SG);
        bf16_t* YC = (bf16_t*)(ws + OFF_YCAT); bf16_t* ST = (bf16_t*)(ws + OFF_ST);
        bf16_t* WA13 = (bf16_t*)(ws + OFF_WA); bf16_t* WA2 = (bf16_t*)(ws + OFF_WA + W13_BYTES);
        bf16_t* WB13 = (bf16_t*)(ws + OFF_WB); bf16_t* WB2 = (bf16_t*)(ws + OFF_WB + W13_BYTES);
        const float* ln_g = INP(18); const float* ln_b = INP(19);
        float* scr = (float*)(smem + wave * 8704);
        if (PRO && (MASK & 1) && ph == 0) {
            TID_SETUP
            cvt_job(INP(4), 1024, 2 * DFF, WA13, 1024, NUP, 0, INP(2), INP(3), cvec + 0, cvec + 5632, scr, gw, NGW, lane);
            cvt_job(INP(5), DFF, 1024, WA2, GW, 1024, 1, nullptr, nullptr, nullptr, nullptr, scr, gw, NGW, lane);
            for (int l = 0; l < 2; ++l) {
                cvt_job(INP(13) + (size_t)l * 65536, 256, 256, (bf16_t*)(ws + OFF_PW) + (size_t)l * 65536, 256, 256, 1, nullptr, nullptr, nullptr, nullptr, scr, gw, NGW, lane);
                bf16_t* ppt = (bf16_t*)(ws + OFF_PP) + (size_t)l * 65536; const float* pw = INP(7) + (size_t)l * 16384; const float* psc = INP(8) + l * 256;
                for (int idx = gtid; idx < 65536; idx += NTH) { const int n = idx >> 8, kk = idx & 255;
                    ppt[idx] = (bf16_t)((kk >> 6) == (n >> 6) ? f2bf(pw[(size_t)((n >> 6) * 64 + (kk & 63)) * 64 + (n & 63)] * psc[n]) : 0u); }
            }
            for (int r0 = gw; r0 < T; r0 += 2 * NGW) {
                const int r1 = r0 + NGW; const bool two = r1 < T; const int r1c = two ? r1 : r0;
                const float* s0 = r0 < TM ? x + (size_t)r0 * 1024 : meta + (size_t)((r0 - TM) & 15) * 1024;
                const float* s1 = r1c < TM ? x + (size_t)r1c * 1024 : meta + (size_t)((r1c - TM) & 15) * 1024;
                f32x4 v[4], w4[4]; float sa = 0.f, ssa = 0.f, sb = 0.f, ssb = 0.f;
#pragma unroll
                for (int j = 0; j < 4; ++j) { v[j] = ((const f32x4*)s0)[lane + 64 * j]; w4[j] = ((const f32x4*)s1)[lane + 64 * j]; }
#pragma unroll
                for (int j = 0; j < 4; ++j) { sa += (v[j].x + v[j].y) + (v[j].z + v[j].w); ssa += (v[j].x * v[j].x + v[j].y * v[j].y) + (v[j].z * v[j].z + v[j].w * v[j].w);
                                              sb += (w4[j].x + w4[j].y) + (w4[j].z + w4[j].w); ssb += (w4[j].x * w4[j].x + w4[j].y * w4[j].y) + (w4[j].z * w4[j].z + w4[j].w * w4[j].w); }
#pragma unroll
                for (int o = 1; o < 64; o <<= 1) { sa += shfl_x(sa, lane, o); ssa += shfl_x(ssa, lane, o); sb += shfl_x(sb, lane, o); ssb += shfl_x(ssb, lane, o); }
#pragma unroll
                for (int j = 0; j < 4; ++j) { u32x2 w; w.x = cvt_pk_bf16(v[j].x, v[j].y); w.y = cvt_pk_bf16(v[j].z, v[j].w); ((u32x2*)(zb + (size_t)r0 * 1024))[lane + 64 * j] = w; }
                if (lane < 16) ((f32x2*)(stats0 + (size_t)r0 * 32))[lane] = lane == 0 ? (f32x2){sa, ssa} : (f32x2){0.f, 0.f};
                if (two) {
#pragma unroll
                    for (int j = 0; j < 4; ++j) { u32x2 w; w.x = cvt_pk_bf16(w4[j].x, w4[j].y); w.y = cvt_pk_bf16(w4[j].z, w4[j].w); ((u32x2*)(zb + (size_t)r1 * 1024))[lane + 64 * j] = w; }
                    if (lane < 16) ((f32x2*)(stats0 + (size_t)r1 * 32))[lane] = lane == 0 ? (f32x2){sb, ssb} : (f32x2){0.f, 0.f};
                }
            }
            {
                double* invt = (double*)(smem + 100352);
                if (tid < 64) invt[tid] = exp2(-(double)tid * (13.287712379549449 / 64.0));
                __syncthreads();
            }
            for (int idx = gtid; idx < LSEQ * 64; idx += NTH) {
                const int t = idx >> 6, i = idx & 63;
                const double inv = ((const double*)(smem + 100352))[i];
                double sn, cs; sincos((double)t * inv, &sn, &cs);
                ((f32x2*)rope)[idx] = (f32x2){(float)cs, (float)sn};
            }
        } else if (PRO && (MASK & 1) && ph == -1) {
            TID_SETUP
            const float* fg = ln_g + 5 * 1024; const float* fb = ln_b + 5 * 1024;
            for (int r = gw; r < TM; r += NGW) {
                f32x4* p = (f32x4*)(zf + (size_t)r * 1024); f32x4 v[4]; float s = 0.f;
#pragma unroll
                for (int j = 0; j < 4; ++j) { v[j] = p[lane + 64 * j]; s += (v[j].x + v[j].y) + (v[j].z + v[j].w); }
                const float mean = wave_sum(s, lane) * (1.f / 1024.f); float s2 = 0.f;
#pragma unroll
                for (int j = 0; j < 4; ++j) { v[j] = v[j] - mean; s2 += (v[j].x * v[j].x + v[j].y * v[j].y) + (v[j].z * v[j].z + v[j].w * v[j].w); }
                const float rstd = rsqrtf(wave_sum(s2, lane) * (1.f / 1024.f) + LN_EPS);
#pragma unroll
                for (int j = 0; j < 4; ++j) { const f32x4 gg = ((const f32x4*)fg)[lane + 64 * j], bb = ((const f32x4*)fb)[lane + 64 * j]; p[lane + 64 * j] = v[j] * rstd * gg + bb; }
            }
        } else if (MID) {
            const int q = ph - 1, l = q / 9, k = q - 9 * l;
            const int par = (3 * l + (k > 1 ? 1 : 0) + (k > 6 ? 1 : 0)) & 1;
            const float* sprev = par ? stats1 : stats0; float* snew = par ? stats0 : stats1;
            cfix_t* cv = cvec + l * 28160;
            bf16_t* win = (bf16_t*)(ws + (l ? OFF_WIO1 : OFF_WIO0)); bf16_t* wout = (bf16_t*)(ws + (l ? OFF_WIO1 : OFF_WIO0) + WIN_BYTES);
            if ((MASK & 2) && (k == 0 || k == 7)) {
                TID_SETUP
                pg8::Gemm g{zb, k == 0 ? WA13 : WB13, 1024}; pg8::StaticOrder S; S.init(TM, NUP, G, bid);
                const LAS float* ctab = (const LAS float*)((LAS unsigned char*)smem + CTAB_OFF);
                {
                    const cfix_t* cc1 = cv + (k == 0 ? 0 : 16896); const cfix_t* cc2 = cv + (k == 0 ? 5632 : 22528);
                    for (int i = 0; i < 6; ++i) { pg8::Unit uu; if (!S.next(i, uu)) break;
                        ((LAS float*)ctab)[i * 512 + tid] = cfix2f((tid < 256 ? cc1 : cc2)[uu.pn * 256 + (tid & 255)]); }
                    __syncthreads();
                }
                EpiUp E{sprev, cv + (k == 0 ? 0 : 16896), cv + (k == 0 ? 5632 : 22528), ws, ctab};
                pg8::gemm_phase<EpiUp>((LAS unsigned char*)smem, g, S, E, tid);
                tail_units<EpiUp>(smem, zb + (size_t)TM * 1024, g.Bt, 1024, NUP / 64, S.nwg % G, E, wave_s * 64 + lane_id_v(), bid);
                if (bid >= 128 && (k == 0 || (l == 0 && k == 7))) {
                    const int gw2 = (bid - 128) * 8 + wave, NGW2 = 128 * 8; const int ln2 = lane_id_v();
                    if (k == 0) {
                        cvt_job(INP(16) + (size_t)l * 1024 * 2 * DFF, 1024, 2 * DFF, WB13, 1024, NUP, 0, ln_g + (3 * l + 1) * 1024, ln_b + (3 * l + 1) * 1024, cv + 16896, cv + 22528, scr, gw2, NGW2, ln2);
                        cvt_job(INP(17) + (size_t)l * DFF * 1024, DFF, 1024, WB2, GW, 1024, 1, nullptr, nullptr, nullptr, nullptr, scr, gw2, NGW2, ln2);
                        if (l == 0) {
                            cvt_job(INP(6), 1024, DIN, win, 1024, DIN, 2, ln_g, ln_b, cv + 11264, cv + 14080, scr, gw2, NGW2, ln2);
                            cvt_job(INP(15), 1024, 1024, wout, 1024, 1024, 1, nullptr, nullptr, nullptr, nullptr, scr, gw2, NGW2, ln2);
                        }
                    } else {
                        cvt_job(INP(4) + (size_t)1024 * 2 * DFF, 1024, 2 * DFF, WA13, 1024, NUP, 0, ln_g + 2 * 1024, ln_b + 2 * 1024, cvec + 28160 + 0, cvec + 28160 + 5632, scr, gw2, NGW2, ln2);
                        cvt_job(INP(5) + (size_t)DFF * 1024, DFF, 1024, WA2, GW, 1024, 1, nullptr, nullptr, nullptr, nullptr, scr, gw2, NGW2, ln2);
                    }
                }
            } else if ((MASK & 4) && (k == 1 || k == 6 || k == 8)) {
                TID_SETUP
                const bool isout = k == 6;
                const int lni = k == 1 ? (l == 0 ? -1 : 2) : (k == 6 ? 3 * l + 0 : 3 * l + 1);
                const float* lg = lni < 0 ? INP(2) : ln_g + lni * 1024; const float* lb = lni < 0 ? INP(3) : ln_b + lni * 1024;
                const bf16_t* Amat = isout ? YC : Gb; const int Kd = isout ? 1024 : GW;
                const bf16_t* Bt = isout ? wout : (k == 1 ? WA2 : WB2);
                pg8::Gemm g{Amat, Bt, Kd}; pg8::StaticOrder S; S.init(TM, 1024, G, bid);
                const LAS float* ctab = (const LAS float*)((LAS unsigned char*)smem + CTAB_OFF);
                {
                    pg8::Unit uu; if (S.next(0, uu)) { const int cc = uu.pn * 256 + (tid & 255);
                        ((LAS float*)ctab)[tid] = (tid < 256 ? lg : lb)[cc]; ((LAS float*)ctab)[512 + tid] = (tid < 256 ? ln_g + 5 * 1024 : ln_b + 5 * 1024)[cc]; }
                    __syncthreads();
                }
                EpiRes E{sprev, snew, lg, lb, zf, ws, isout ? 1.0f : 0.5f,
                         (l == 1 && k == 8) ? 1 : 0, ln_g + 5 * 1024, ln_b + 5 * 1024, (unsigned*)(ws + OFF_CTL + 14336), ctab};
                pg8::gemm_phase<EpiRes>((LAS unsigned char*)smem, g, S, E, tid);
                if (!E.fin) tail_units<EpiRes>(smem, Amat + (size_t)TM * Kd, Bt, Kd, 16, S.nwg % G, E, wave_s * 64 + lane_id_v(), bid);
            } else if ((MASK & 8) && k == 2) {
                TID_SETUP
                pg8::Gemm g{zb, win, 1024}; pg8::StaticOrder S; S.init(TM, DIN, G, bid);
                const LAS float* ctab = (const LAS float*)((LAS unsigned char*)smem + CTAB_OFF);
                {
                    const cfix_t* cc1 = cv + 11264; const cfix_t* cc2 = cv + 14080;
                    for (int i = 0; i < 3; ++i) { pg8::Unit uu; if (!S.next(i, uu)) break;
                        ((LAS float*)ctab)[i * 512 + tid] = cfix2f((tid < 256 ? cc1 : cc2)[uu.pn * 256 + (tid & 255)]); }
                    __syncthreads();
                }
                EpiIn E{sprev, cv + 11264, cv + 14080, ws, ctab};
                pg8::gemm_phase<EpiIn>((LAS unsigned char*)smem, g, S, E, tid);
                tail_units<EpiIn>(smem, zb + (size_t)TM * 1024, win, 1024, DIN / 64, S.nwg % G, E, wave_s * 64 + lane_id_v(), bid);
                if (l == 0 && bid >= 192) {
                    const int gw2 = (bid - 192) * 8 + wave, NGW2 = 64 * 8; const int ln2 = lane_id_v();
                    cvt_job(INP(6) + (size_t)1024 * DIN, 1024, DIN, (bf16_t*)(ws + OFF_WIO1), 1024, DIN, 2, ln_g + 3 * 1024, ln_b + 3 * 1024, cvec + 28160 + 11264, cvec + 28160 + 14080, scr, gw2, NGW2, ln2);
                    cvt_job(INP(15) + (size_t)1024 * 1024, 1024, 1024, (bf16_t*)(ws + OFF_WIO1 + WIN_BYTES), 1024, 1024, 1, nullptr, nullptr, nullptr, nullptr, scr, gw2, NGW2, ln2);
                }
            } else if ((MASK & 16) && k == 3) {
                TID_SETUP
                const bf16_t* PWT = (const bf16_t*)(ws + OFF_PW) + (size_t)l * 65536; const bf16_t* PPT = (const bf16_t*)(ws + OFF_PP) + (size_t)l * 65536;
                const float* dw = INP(9) + (size_t)l * 31 * 256; const float* db = INP(10) + l * 256;
                const float* cg_ = INP(11) + l * 256; const float* cb_ = INP(12) + l * 256;
                constexpr int NCV = 258, NPL = 258, NKV = 1024;
                for (int j = 0; j < 7; ++j) {
                    int it = -1; bool pair = false;
                    if (j == 0) it = bid;
                    else if (j == 1) { if (bid < 2) it = 256 + bid; }
                    else if (j == 2) it = NCV + bid;
                    else if (j == 3) { if (bid >= 2 && bid < 4) it = NCV + 256 + (bid - 2); }
                    else if (j < 6) { pair = true; if (bid >= 4) it = NCV + NPL + 4 * (bid - 4) + 2 * (j - 4); else if (bid >= 2 && j == 4) it = NCV + NPL + 1008 + 2 * (bid - 2); }
                    else { if (bid >= 4 && bid < 16) it = NCV + NPL + 1012 + (bid - 4); }
                    if (it < 0) continue;
                    asm volatile("" : "+v"(tid));
                    if (it < NCV) conv_item(smem, U, PWT, dw, db, cg_, cb_, YC, it / 129, it % 129, tid);
                    else if (it < NCV + NPL) pool_item(smem, XP, PPT, YC, (it - NCV) / 129, (it - NCV) % 129, tid);
                    else { const int kk = it - NCV - NPL; if (pair) kv_item<2>(smem, Kb, V, ST, kk >> 7, kk & 127, tid); else kv_item<1>(smem, Kb, V, ST, kk >> 7, kk & 127, tid); }
                }
            } else if ((MASK & 64) && k == 4) {
                TID_SETUP
                {
                    const int d = gtid & 127, e = (gtid >> 7) & 127, bh = gtid >> 14, h = bh & 3;
                    const float g64 = exp2f(64.f * log2_gamma(h));
                    bf16_t* p = ST + (size_t)bh * NCHUNK * 16384 + e * 128 + d;
                    float Sv = 0.f;
#pragma unroll 1
                    for (int n0 = 0; n0 < NCHUNK - 1; n0 += 32) {
                        unsigned short kvb[32];
#pragma unroll
                        for (int j = 0; j < 32; ++j) kvb[j] = p[(size_t)(n0 + j) * 16384];
#pragma unroll
                        for (int j = 0; j < 32; ++j) { p[(size_t)(n0 + j) * 16384] = (bf16_t)f2bf(Sv); Sv = g64 * Sv + bf2f(kvb[j]); }
                    }
                    p[(size_t)(NCHUNK - 1) * 16384] = (bf16_t)f2bf(Sv);
                }
            } else if ((MASK & 32) && k == 5) {
                TID_SETUP
                const float* gng = INP(14) + l * 512;
                RetRegs R;
                { const int bh0 = bid < 1024 ? (bid >> 7) : (bid - 1024), n0_ = bid < 1024 ? 1 + (bid & 127) : 0; ret_load(R, Q, Kb, V, ST, SG, bh0, n0_, tid); }
                for (int it = bid; it < 1032; it += G) {
                    const int bh = it < 1024 ? (it >> 7) : (it - 1024), n = it < 1024 ? 1 + (it & 127) : 0;
                    const int itn = it + G; const bool hn = itn < 1032;
                    const int nbh = itn < 1024 ? (itn >> 7) : (itn - 1024), nn = itn < 1024 ? 1 + (itn & 127) : 0;
                    ret_item(smem, R, Q, Kb, V, ST, SG, gng, YC, bh, n, hn, hn ? nbh : bh, hn ? nn : n, tid);
                }
            }
        }
}

template <int MASK>
__global__ void __launch_bounds__(512, 2) mk_fwd(Args a) {
    extern __shared__ __attribute__((aligned(16))) unsigned char smem[];
    constexpr int G = GRID, NGW = G * 8, NTH = G * 512;
    volatile LAS unsigned* misc = (volatile LAS unsigned*)((LAS unsigned char*)smem + MISC_OFF);
    if (threadIdx.x < 64) misc[threadIdx.x] = 0u;
    volatile LAS unsigned* ptab = misc + 64;
    if (threadIdx.x == 0) {
#pragma unroll
        for (int i = 0; i < 20; ++i) { const unsigned long long p = (unsigned long long)a.in[i]; ptab[2 * i] = (unsigned)p; ptab[2 * i + 1] = (unsigned)(p >> 32); }
    }
    __syncthreads();
    XcdBarrier bar = xcd_barrier_post((unsigned*)(a.ws + OFF_CTL), misc + 8);
    const int wave_s = __builtin_amdgcn_readfirstlane((int)(threadIdx.x >> 6));
    if (a.ph_lo <= 0 && a.ph_hi > 0) {
        run_phase<true, false, MASK>(a, smem, ptab, 0, G, NGW, NTH, wave_s);
        if (a.ph_hi > 1) { if (a.use_cg) cg::this_grid().sync(); else xcd_barrier(bar, wave_s); }
    }
    for (int ph = (a.ph_lo > 1 ? a.ph_lo : 1); ph < (a.ph_hi < NPH ? a.ph_hi : NPH); ++ph) {
        if (ph > 1 && ph > a.ph_lo) xcd_barrier(bar, wave_s);
        run_phase<false, true, MASK>(a, smem, ptab, ph, G, NGW, NTH, wave_s);
    }
}

template <int MASK> static void launch_plain(const Args& a, int grid, hipStream_t stream) {
    static bool attr = false;
    if (!attr) { (void)hipFuncSetAttribute((const void*)mk_fwd<MASK>, hipFuncAttributeMaxDynamicSharedMemorySize, LDS_BYTES); attr = true; }
    hipLaunchKernelGGL(mk_fwd<MASK>, dim3(grid), dim3(512), LDS_BYTES, stream, a);
}
extern "C" void kernel_launch(void* const* d_in, const int* in_sizes, int n_in, void* d_out, int out_size, void* d_ws, size_t ws_size, hipStream_t stream) {
    static int grid = 0;
    if (grid == 0) {
        if (n_in != 20 || out_size != TM * D || ws_size < WS_END) { fprintf(stderr, "kernel_launch: unexpected shapes (n_in %d, out %d, ws %zu, need %zu)\n", n_in, out_size, ws_size, (size_t)WS_END); grid = -1; return; }
        int dev = 0, cus = 0;
        (void)hipGetDevice(&dev); (void)hipDeviceGetAttribute(&cus, hipDeviceAttributeMultiprocessorCount, dev);
#if ONE_LAUNCH
        if (hipFuncSetAttribute((const void*)mk_fwd<127>, hipFuncAttributeMaxDynamicSharedMemorySize, LDS_BYTES) != hipSuccess) { fprintf(stderr, "kernel_launch: hipFuncSetAttribute failed\n"); grid = -1; return; }
#endif
        grid = GRID;
        if (cus != GRID) fprintf(stderr, "kernel_launch: warning: %d CUs, kernel built for %d\n", cus, GRID);
    }
    if (grid < 0) return;
    (void)hipMemsetAsync(d_ws, 0, ZERO_BYTES, stream);
    Args a{};
    for (int i = 0; i < 20; ++i) a.in[i] = (const float*)d_in[i];
    a.out = (float*)d_out; a.ws = (unsigned char*)d_ws; a.use_cg = 0; a.pad = 0;
#if ONE_LAUNCH
    a.ph_lo = 0; a.ph_hi = NPH;
    void* args[] = {&a};
    hipError_t e = hipLaunchCooperativeKernel((const void*)mk_fwd<127>, dim3(grid), dim3(512), args, LDS_BYTES, stream);
    if (e != hipSuccess) fprintf(stderr, "cooperative launch failed: %s (grid %d)\n", hipGetErrorString(e), grid);
#if PROBE_SET
    {
        static bool attr = false;
        if (!attr) { (void)hipFuncSetAttribute((const void*)mk_fwd<127>, hipFuncAttributeMaxDynamicSharedMemorySize, LDS_BYTES); attr = true; }
        for (int ph = 1; ph < NPH; ++ph) {
            const int k = (ph - 1) % 9;
            const bool sel = PROBE_SET == 1 ? (k == 0 || k == 7 || k == 2) : PROBE_SET == 2 ? (k == 3 || k == 4 || k == 5) : PROBE_SET == 3 ? (k == 0 || k == 7) : PROBE_SET == 4 ? (k == 3) : PROBE_SET == 5 ? (k == 4) : (k == 5);
            if (!sel) continue;
            a.ph_lo = ph; a.ph_hi = ph + 1;
            hipLaunchKernelGGL(mk_fwd<127>, dim3(grid), dim3(512), LDS_BYTES, stream, a);
        }
    }
#endif
#else
    for (int ph = 0; ph < NPH; ++ph) {
        a.ph_lo = ph; a.ph_hi = ph + 1;
        if (ph == 0) { launch_plain<1>(a, grid, stream); continue; }
        const int k = (ph - 1) % 9;
        if (k == 0 || k == 7) launch_plain<2>(a, grid, stream);
        else if (k == 1 || k == 6 || k == 8) launch_plain<4>(a, grid, stream);
        else if (k == 2) launch_plain<8>(a, grid, stream);
        else if (k == 3) launch_plain<16>(a, grid, stream);
        else if (k == 4) launch_plain<64>(a, grid, stream);
        else launch_plain<32>(a, grid, stream);
    }
#endif
}
```

```cpp
#include <hip/hip_runtime.h>
#include <hip/hip_cooperative_groups.h>
#include <cstdio>
#include <cstdint>
namespace cg = cooperative_groups;

#define LAS __attribute__((address_space(3)))
typedef unsigned short bf16_t;
typedef short bf16x8 __attribute__((ext_vector_type(8)));
typedef float f32x4 __attribute__((ext_vector_type(4)));
typedef float f32x16 __attribute__((ext_vector_type(16)));
typedef float f32x2 __attribute__((ext_vector_type(2)));
typedef unsigned u32x4 __attribute__((ext_vector_type(4)));
typedef unsigned u32x2 __attribute__((ext_vector_type(2)));

#ifndef EN_PRO
#define EN_PRO 1
#endif
#ifndef EN_UP
#define EN_UP 1
#endif
#ifndef EN_RES
#define EN_RES 1
#endif
#ifndef EN_IN
#define EN_IN 1
#endif
#ifndef EN_M1
#define EN_M1 1
#endif
#ifndef EN_M2
#define EN_M2 1
#endif
#ifndef PROBE_SET
#define PROBE_SET 0
#endif
#ifndef ONE_LAUNCH
#define ONE_LAUNCH 1
#endif

constexpr int D = 1024, SEQ = 8192, NMETA = 16, LSEQ = SEQ + NMETA, NB = 2;
constexpr int TM = NB * SEQ;
constexpr int T = TM + NB * NMETA;
constexpr int DFF = 2752, GW = 2816, NUP = 5632, DIN = 2816;
constexpr int NCHUNK = 129;
constexpr float ALPHA = 1.41421356237309515f;
constexpr float LN_EPS = 1e-5f;
constexpr int NPH = 19;
constexpr int GRID = 256;

constexpr size_t OFF_CTL = 0;
constexpr size_t OFF_CVEC = 16384;
constexpr size_t ZERO_BYTES = 524288;
constexpr size_t OFF_ZFM = 524288;
constexpr size_t OFF_STATS = OFF_ZFM + 32 * 1024 * 4;
constexpr size_t STATS_BYTES = (size_t)T * 32 * 4;
constexpr size_t OFF_ROPE = OFF_STATS + 2 * STATS_BYTES;
constexpr size_t OFF_PW = OFF_ROPE + (size_t)LSEQ * 64 * 8;
constexpr size_t OFF_PP = OFF_PW + 2 * 131072;
constexpr size_t OFF_WA = OFF_PP + 2 * 131072;
constexpr size_t W13_BYTES = (size_t)NUP * 1024 * 2, W2_BYTES = (size_t)1024 * GW * 2;
constexpr size_t OFF_WB = OFF_WA + W13_BYTES + W2_BYTES;
constexpr size_t OFF_WIO0 = OFF_WB + W13_BYTES + W2_BYTES;
constexpr size_t WIN_BYTES = (size_t)DIN * 1024 * 2, WOUT_BYTES = (size_t)1024 * 1024 * 2;
constexpr size_t OFF_WIO1 = OFF_WIO0 + WIN_BYTES + WOUT_BYTES;
constexpr size_t OFF_ZB = OFF_WIO1 + WIN_BYTES + WOUT_BYTES;
constexpr size_t OFF_R = OFF_ZB + (size_t)T * 1024 * 2;
constexpr size_t OFF_G = OFF_R;
constexpr size_t OFF_XP = OFF_R;
constexpr size_t OFF_U = OFF_XP + (size_t)T * 256 * 2;
constexpr size_t OFF_Q = OFF_U + (size_t)T * 256 * 2;
constexpr size_t OFF_K = OFF_Q + (size_t)T * 512 * 2;
constexpr size_t OFF_K2 = OFF_K + (size_t)T * 512 * 2;
constexpr size_t OFF_V = OFF_K2 + (size_t)T * 512 * 2;
constexpr size_t OFF_SG = OFF_V + (size_t)T * 512 * 2;
constexpr size_t OFF_YCAT = OFF_SG + (size_t)T * 512 * 2;
constexpr size_t OFF_ST = OFF_YCAT + (size_t)T * 1024 * 2;
constexpr size_t WS_END = OFF_ST + (size_t)NB * 4 * NCHUNK * 16384 * 2;
static_assert(OFF_G + (size_t)T * GW * 2 <= WS_END, "G fits");
static_assert(WS_END <= (size_t)268435456, "workspace budget");

constexpr int LDS_BYTES = 147456;
constexpr int MISC_OFF = 131072;
constexpr int CTAB_OFF = MISC_OFF + 1024;
typedef short v4i16_t __attribute__((ext_vector_type(4)));

__device__ __forceinline__ unsigned f2bf(float f) { unsigned u = __float_as_uint(f); return (u + 0x7fffu + ((u >> 16) & 1u)) >> 16; }
__device__ __forceinline__ float bf2f(unsigned h) { return __uint_as_float(h << 16); }
typedef __bf16 bf16x2_t __attribute__((ext_vector_type(2)));
__device__ __forceinline__ unsigned cvt_pk_bf16(float lo, float hi) { const f32x2 v = {lo, hi}; const bf16x2_t r = __builtin_convertvector(v, bf16x2_t); return __builtin_bit_cast(unsigned, r); }
__device__ __forceinline__ int lane_id_v() { int l; asm volatile("v_mbcnt_lo_u32_b32 %0, -1, 0\n\tv_mbcnt_hi_u32_b32 %0, -1, %0" : "=v"(l)); return l; }
__device__ __forceinline__ float shfl_i(float v, int src) { return __builtin_bit_cast(float, __builtin_amdgcn_ds_bpermute(src << 2, __builtin_bit_cast(int, v))); }
__device__ __forceinline__ float shfl_x(float v, int lane, int m) { return shfl_i(v, lane ^ m); }
__device__ __forceinline__ float wave_sum(float v, int lane) {
#pragma unroll
    for (int o = 1; o < 64; o <<= 1) v += shfl_x(v, lane, o);
    return v;
}
typedef long long cfix_t;
__device__ __forceinline__ float cfix2f(cfix_t v) { return (float)((double)v * (1.0 / 4294967296.0)); }
__device__ __forceinline__ f32x4 ldc4(const cfix_t* p) { const u32x4 a = *(const u32x4*)p, b = *(const u32x4*)(p + 2);
    return (f32x4){cfix2f((cfix_t)(((unsigned long long)a.y << 32) | a.x)), cfix2f((cfix_t)(((unsigned long long)a.w << 32) | a.z)), cfix2f((cfix_t)(((unsigned long long)b.y << 32) | b.x)), cfix2f((cfix_t)(((unsigned long long)b.w << 32) | b.z))}; }
__device__ __forceinline__ float fast_sigmoid(float x) { return __builtin_amdgcn_rcpf(1.0f + __builtin_amdgcn_exp2f(-1.4426950408889634f * x)); }
__device__ __forceinline__ float silu_f(float x) { return x * fast_sigmoid(x); }
__device__ __forceinline__ int tok_row(int b, int t) { return t < NMETA ? TM + NMETA * b + t : SEQ * b + t - NMETA; }
__device__ __forceinline__ void row_bt(int r, int& b, int& t) { if (r < TM) { b = r >> 13; t = (r & 8191) + NMETA; } else { const int m = r - TM; b = m >> 4; t = m & 15; } }
__device__ __forceinline__ float log2_gamma(int h) { return __log2f(1.0f - exp2f(-5.0f - (float)h)); }
__device__ __forceinline__ void stat_finish(float s, float ss, float& mu, float& rs) { mu = s * (1.f / 1024.f); const float var = ss * (1.f / 1024.f) - mu * mu; rs = rsqrtf(fmaxf(var, 0.f) + LN_EPS); }
__device__ __forceinline__ void load_row_stat(const float* stats, int r, float& mu, float& rs) {
    const f32x4* p = (const f32x4*)(stats + (size_t)r * 32); float s = 0.f, ss = 0.f;
#pragma unroll
    for (int k = 0; k < 8; ++k) { const f32x4 v = p[k]; s += v.x + v.z; ss += v.y + v.w; }
    stat_finish(s, ss, mu, rs);
}

struct UnitStats {
    float mu0, rs0, mu1, rs1;
    __device__ __forceinline__ void load(const float* stats, int rowbase, int lane) { load_row_stat(stats, rowbase + lane, mu0, rs0); load_row_stat(stats, rowbase + 128 + lane, mu1, rs1); }
    __device__ __forceinline__ void get(int ai, int m, int fr, float& mu, float& rs) const { const int src = 16 * m + fr; mu = shfl_i(ai ? mu1 : mu0, src); rs = shfl_i(ai ? rs1 : rs0, src); }
};

namespace pg8 {
constexpr int BM = 256, BK = 64, HALF = 128, HTB = HALF * BK * 2, STAGE_BYTES = 8 * HTB, NXCD = 8, WGM = 8;
__host__ __device__ __forceinline__ int lds_byte(int r, int c) { const int st = (r >> 4) * 2 + (c >> 5), rr = r & 15, cc = c & 31, ob = rr * 64 + cc * 2; return st * 1024 + (ob ^ (((ob >> 9) & 1) << 5)); }
__host__ __device__ __forceinline__ void stage_rc(int b, int& R, int& C) { const int st = b / 1024, sb = b % 1024, swz = sb ^ (((sb >> 9) & 1) << 5); R = (st >> 1) * 16 + swz / 64; C = (st & 1) * 32 + (swz % 64) / 2; }
__host__ __device__ __forceinline__ int perm32(int rho) { const int n = rho >> 4, i = rho & 15; return 8 * (i >> 2) + 4 * n + (i & 3); }
struct Unit { int pm, pn; };
struct Gemm { const bf16_t* A; const bf16_t* Bt; int K; };
struct StaticOrder {
    int nM, nN, nwg, G, c;
    __device__ void init(int M, int N, int G_, int c_) { nM = M / BM; nN = N / BM; nwg = nM * nN; G = G_; c = c_; }
    __device__ bool next(int i, Unit& u) const {
        const long L = (long)i * G + c; if (L >= nwg) return false;
        int wgid = (int)L; { const int q = nwg / NXCD, r = nwg % NXCD, xcd = wgid % NXCD, off = wgid / NXCD; wgid = (xcd < r ? xcd * (q + 1) : r * (q + 1) + (xcd - r) * q) + off; }
        const int nig = WGM * nN, gid = wgid / nig, fm = gid * WGM, gsz = (nM - fm) < WGM ? (nM - fm) : WGM;
        u.pm = __builtin_amdgcn_readfirstlane(fm + ((wgid % nig) % gsz)); u.pn = __builtin_amdgcn_readfirstlane((wgid % nig) / gsz); return true;
    }
};

template <class Epi>
__device__ __forceinline__ void gemm_phase(LAS unsigned char* lds, const Gemm g, const StaticOrder& S, const Epi& E, const int tid) {
    const int wid = __builtin_amdgcn_readfirstlane(tid >> 6), lane = tid & 63, wr = wid >> 2, wc = wid & 3, fr = lane & 15, fq = lane >> 4;
    const int K = g.K, nt = K / BK;
    unsigned voffA[2], voffB[2];
#pragma unroll
    for (int i = 0; i < 2; ++i) { int R, C; stage_rc(tid * 16 + i * 8192, R, C); const int Rb = Epi::PERM ? ((R & ~31) + perm32(R & 31)) : R;
        voffA[i] = (unsigned)(R * K + C) * 2u; voffB[i] = (unsigned)(Rb * K + C) * 2u; }
    const size_t kstep = (size_t)(BK * 2);
    const size_t hstep = (size_t)HALF * K * 2;
    const size_t tstep = 2 * hstep;
    const unsigned ldsw = (unsigned)wid * 1024u;
    const int aoff = lds_byte(wr * 64 + fr, fq * 8), boff = lds_byte(wc * 32 + fr, fq * 8);
#define PG8_SA(b, h) (((b) * 2 + (h)) * HTB)
#define PG8_SB(b, h) ((4 + (b) * 2 + (h)) * HTB)
#define PG8_STAGE(bufoff, gbase, voff) do { _Pragma("unroll") for (int _i = 0; _i < 2; ++_i) \
        __builtin_amdgcn_global_load_lds((const unsigned*)((const char*)(gbase) + (voff)[_i]), (LAS unsigned*)(lds + (bufoff) + ldsw + _i * 8192), 16, 0, 0); } while (0)
#define PG8_LDA(dst, b, h) do { _Pragma("unroll") for (int m = 0; m < 4; ++m) _Pragma("unroll") for (int k = 0; k < 2; ++k) dst[m][k] = *(const LAS bf16x8*)(lds + PG8_SA(b, h) + aoff + m * 2048 + k * 1024); } while (0)
#define PG8_LDB(dst, b, h) do { _Pragma("unroll") for (int n = 0; n < 2; ++n) _Pragma("unroll") for (int k = 0; k < 2; ++k) dst[n][k] = *(const LAS bf16x8*)(lds + PG8_SB(b, h) + boff + n * 2048 + k * 1024); } while (0)
#define PG8_MMA(ai, bj, At, Bt) do { __builtin_amdgcn_s_setprio(1); _Pragma("unroll") for (int m = 0; m < 4; ++m) _Pragma("unroll") for (int n = 0; n < 2; ++n) _Pragma("unroll") for (int k = 0; k < 2; ++k) \
        acc[ai][bj][m][n] = __builtin_amdgcn_mfma_f32_16x16x32_bf16(Bt[n][k], At[m][k], acc[ai][bj][m][n], 0, 0, 0); __builtin_amdgcn_s_setprio(0); } while (0)
#define PG8_WAIT_V(n) asm volatile("s_waitcnt vmcnt(" #n ")" ::: "memory")
#define PG8_WAIT_L(n) asm volatile("s_waitcnt lgkmcnt(" #n ")" ::: "memory")
#define PG8_BAR __builtin_amdgcn_s_barrier()
#define PG8_SCHED __builtin_amdgcn_sched_barrier(0)
    Unit cur, nxt; int ui = 0;
    if (!S.next(0, cur)) return;
    UnitStats stn;
    stn.load(E.stats, cur.pm * 256 + wr * 64, lane);
    f32x4 acc[2][2][4][2];
#pragma unroll
    for (int a = 0; a < 2; ++a)
#pragma unroll
        for (int b = 0; b < 2; ++b)
#pragma unroll
            for (int m = 0; m < 4; ++m)
#pragma unroll
                for (int n = 0; n < 2; ++n) acc[a][b][m][n] = (f32x4){0.f, 0.f, 0.f, 0.f};
    bf16x8 At[4][2], B0[2][2], B1[2][2];
    const char* cA = (const char*)g.A + (size_t)cur.pm * tstep; const char* cB = (const char*)g.Bt + (size_t)cur.pn * tstep;
    PG8_STAGE(PG8_SB(0, 0), cB, voffB); PG8_STAGE(PG8_SB(0, 1), cB + hstep, voffB); PG8_STAGE(PG8_SA(0, 0), cA, voffA); PG8_STAGE(PG8_SA(0, 1), cA + hstep, voffA);
    if (wr == 1) PG8_BAR;
    PG8_WAIT_V(2); PG8_BAR;
    PG8_STAGE(PG8_SB(1, 0), cB + kstep, voffB); PG8_STAGE(PG8_SA(1, 0), cA + kstep, voffA); PG8_STAGE(PG8_SB(1, 1), cB + hstep + kstep, voffB);
    PG8_WAIT_V(6); PG8_BAR;
    for (;;) {
        const bool has_next = S.next(ui + 1, nxt);
        const char* nA = has_next ? (const char*)g.A + (size_t)nxt.pm * tstep : cA; const char* nB = has_next ? (const char*)g.Bt + (size_t)nxt.pn * tstep : cB;
        for (int t = 0; t < nt; t += 2) {
            const bool last = (t == nt - 2);
            const char* a1 = cA + (size_t)(t + 1) * kstep;
            const char* a2 = last ? nA : cA + (size_t)(t + 2) * kstep; const char* b2 = last ? nB : cB + (size_t)(t + 2) * kstep;
            const char* a3 = a2 + kstep; const char* b3 = b2 + kstep;
            PG8_LDB(B0, 0, 0); PG8_LDB(B1, 0, 1); PG8_SCHED; PG8_LDA(At, 0, 0); PG8_STAGE(PG8_SA(1, 1), a1 + hstep, voffA);
            PG8_WAIT_V(8); PG8_WAIT_L(0); PG8_BAR; PG8_MMA(0, 0, At, B0); PG8_MMA(0, 1, At, B1); PG8_BAR; PG8_SCHED;
            PG8_LDA(At, 0, 1); PG8_STAGE(PG8_SB(0, 0), b2, voffB); PG8_STAGE(PG8_SB(0, 1), b2 + hstep, voffB); PG8_STAGE(PG8_SA(0, 0), a2, voffA);
            PG8_WAIT_V(8); PG8_WAIT_L(0); PG8_BAR; PG8_MMA(1, 0, At, B0); PG8_MMA(1, 1, At, B1); PG8_BAR; PG8_SCHED;
            PG8_LDB(B0, 1, 0); PG8_LDB(B1, 1, 1); PG8_SCHED; PG8_LDA(At, 1, 0); PG8_STAGE(PG8_SA(0, 1), a2 + hstep, voffA);
            PG8_WAIT_V(8); PG8_WAIT_L(0); PG8_BAR; PG8_MMA(0, 0, At, B0); PG8_MMA(0, 1, At, B1); PG8_BAR; PG8_SCHED;
            PG8_LDA(At, 1, 1); PG8_STAGE(PG8_SB(1, 0), b3, voffB); PG8_STAGE(PG8_SB(1, 1), b3 + hstep, voffB); PG8_STAGE(PG8_SA(1, 0), a3, voffA);
            PG8_WAIT_V(8); PG8_WAIT_L(0); PG8_BAR; PG8_MMA(1, 0, At, B0); PG8_MMA(1, 1, At, B1); PG8_BAR; PG8_SCHED;
        }
        if (wr == 0) PG8_BAR;
        { const int l2 = lane_id_v(); E(acc, cur, wr, wc, l2 & 15, l2 >> 4, stn, ui); if (has_next) stn.load(E.stats, nxt.pm * 256 + wr * 64, l2); }
        if (!has_next) break;
#pragma unroll
        for (int a = 0; a < 2; ++a)
#pragma unroll
            for (int b = 0; b < 2; ++b)
#pragma unroll
                for (int m = 0; m < 4; ++m)
#pragma unroll
                    for (int n = 0; n < 2; ++n) acc[a][b][m][n] = (f32x4){0.f, 0.f, 0.f, 0.f};
        cur = nxt; cA = nA; cB = nB; ++ui;
        if (wr == 1) PG8_BAR;
    }
    PG8_WAIT_V(0);
    PG8_BAR;
#undef PG8_SA
#undef PG8_SB
#undef PG8_STAGE
#undef PG8_LDA
#undef PG8_LDB
#undef PG8_MMA
#undef PG8_WAIT_V
#undef PG8_WAIT_L
#undef PG8_BAR
#undef PG8_SCHED
}
}


struct EpiUp {
    static constexpr bool PERM = true;
    const float* stats; const cfix_t* c1; const cfix_t* c2; unsigned char* ws; const LAS float* ctab;
    __device__ __forceinline__ void operator()(const f32x4 (&acc)[2][2][4][2], const pg8::Unit& u, int wr, int wc, int fr, int fq, const UnitStats& st, int ui) const {
        asm volatile("" : "+v"(fr), "+v"(fq));
        const int lane = fr + 16 * fq, rowbase = u.pm * 256 + wr * 64;
        const int n0 = u.pn * 256 + wc * 32 + 8 * fq, gcol = u.pn * 128 + wc * 32 + 8 * fq;
        bf16_t* G = (bf16_t*)(ws + OFF_G);
        f32x4 ka1[2], ka2[2], ku1[2], ku2[2];
#pragma unroll
        for (int n = 0; n < 2; ++n) { const LAS float* ct = ctab + ui * 512 + wc * 32 + 8 * fq + 4 * n; ka1[n] = *(const LAS f32x4*)ct; ka2[n] = *(const LAS f32x4*)(ct + 256); ku1[n] = *(const LAS f32x4*)(ct + 128); ku2[n] = *(const LAS f32x4*)(ct + 384); }
#pragma unroll
        for (int ai = 0; ai < 2; ++ai)
#pragma unroll
            for (int m = 0; m < 4; ++m) {
                float mu, rs; st.get(ai, m, fr, mu, rs);
                const int r = rowbase + 128 * ai + 16 * m + fr;
                float o[8];
#pragma unroll
                for (int n = 0; n < 2; ++n) {
#pragma unroll
                    for (int j = 0; j < 4; ++j) {
                        const float av = rs * (acc[ai][0][m][n][j] - mu * ka1[n][j]) + ka2[n][j];
                        const float uu = rs * (acc[ai][1][m][n][j] - mu * ku1[n][j]) + ku2[n][j];
                        o[4 * n + j] = silu_f(av) * uu;
                    }
                }
                u32x4 w; w.x = cvt_pk_bf16(o[0], o[1]); w.y = cvt_pk_bf16(o[2], o[3]); w.z = cvt_pk_bf16(o[4], o[5]); w.w = cvt_pk_bf16(o[6], o[7]);
                __builtin_nontemporal_store(w, (u32x4*)(G + (size_t)r * GW + gcol));
            }
    }
    __device__ __forceinline__ void tail(int u, int row, int c, float p0, float p1, float q0, float q1) const {
        const int r = TM + row, n0 = (u >> 2) * 256 + (u & 3) * 32 + c, gcol = (u >> 2) * 128 + (u & 3) * 32 + c;
        float mu, rs; load_row_stat(stats, r, mu, rs);
        const float a0 = rs * (p0 - mu * cfix2f(c1[n0])) + cfix2f(c2[n0]), a1 = rs * (p1 - mu * cfix2f(c1[n0 + 1])) + cfix2f(c2[n0 + 1]);
        const float u0 = rs * (q0 - mu * cfix2f(c1[n0 + 128])) + cfix2f(c2[n0 + 128]), u1 = rs * (q1 - mu * cfix2f(c1[n0 + 129])) + cfix2f(c2[n0 + 129]);
        *(unsigned*)((bf16_t*)(ws + OFF_G) + (size_t)r * GW + gcol) = cvt_pk_bf16(silu_f(a0) * u0, silu_f(a1) * u1);
    }
};

struct EpiRes {
    static constexpr bool PERM = false;
    const float* stats; float* stats_new; const float* lg; const float* lb; float* zf; unsigned char* ws; float bscale;
    int fin; const float* fg; const float* fb; unsigned* cnt; const LAS float* ctab;
    __device__ __forceinline__ void operator()(f32x4 (&acc)[2][2][4][2], const pg8::Unit& u, int wr, int wc, int fr, int fq, const UnitStats& st, int ui) const {
        asm volatile("" : "+v"(fr), "+v"(fq));
        const int lane = fr + 16 * fq, rowbase = u.pm * 256 + wr * 64;
        const int col0 = u.pn * 256 + wc * 32 + 4 * fq;
        bf16_t* zb = (bf16_t*)(ws + OFF_ZB);
        f32x4 gvh[2][2], bvh[2][2];
#pragma unroll
        for (int bj = 0; bj < 2; ++bj)
#pragma unroll
            for (int n = 0; n < 2; ++n) { const LAS float* ct = ctab + wc * 32 + 4 * fq + 128 * bj + 16 * n; gvh[bj][n] = *(const LAS f32x4*)ct; bvh[bj][n] = *(const LAS f32x4*)(ct + 256); }
        u32x2 zp[2][2];
        { const bf16_t* z0 = zb + (size_t)(rowbase + fr) * 1024 + col0;
#pragma unroll
          for (int bj = 0; bj < 2; ++bj)
#pragma unroll
            for (int n = 0; n < 2; ++n) zp[bj][n] = *(const u32x2*)(z0 + 128 * bj + 16 * n); }
#pragma unroll
        for (int ai = 0; ai < 2; ++ai)
#pragma unroll
            for (int m = 0; m < 4; ++m) {
                float mu, rs; st.get(ai, m, fr, mu, rs);
                const int r = rowbase + 128 * ai + 16 * m + fr;
                bf16_t* br = zb + (size_t)r * 1024 + col0;
                f32x4 zc[2][2];
#pragma unroll
                for (int bj = 0; bj < 2; ++bj)
#pragma unroll
                    for (int n = 0; n < 2; ++n) { const u32x2 q = zp[bj][n]; zc[bj][n] = (f32x4){bf2f(q.x & 0xffffu), bf2f(q.x >> 16), bf2f(q.y & 0xffffu), bf2f(q.y >> 16)}; }
                if (ai * 4 + m < 7) {
                    const int rn = rowbase + 128 * ((ai * 4 + m + 1) >> 2) + 16 * ((ai * 4 + m + 1) & 3) + fr;
                    const bf16_t* zn_ = zb + (size_t)rn * 1024 + col0;
#pragma unroll
                    for (int bj = 0; bj < 2; ++bj)
#pragma unroll
                        for (int n = 0; n < 2; ++n) zp[bj][n] = *(const u32x2*)(zn_ + 128 * bj + 16 * n);
                }
                float s = 0.f, ss = 0.f;
#pragma unroll
                for (int bj = 0; bj < 2; ++bj)
#pragma unroll
                    for (int n = 0; n < 2; ++n) {
                        f32x4 zn;
                        const f32x4 gv = gvh[bj][n], bv = bvh[bj][n];
#pragma unroll
                        for (int j = 0; j < 4; ++j) { const float h = (zc[bj][n][j] - mu) * rs * gv[j] + bv[j]; zn[j] = ALPHA * h + bscale * acc[ai][bj][m][n][j]; s += zn[j]; ss += zn[j] * zn[j]; }
                        acc[ai][bj][m][n] = zn;
                        if (!fin) {
                            u32x2 w; w.x = cvt_pk_bf16(zn[0], zn[1]); w.y = cvt_pk_bf16(zn[2], zn[3]);
                            *(u32x2*)(br + 128 * bj + 16 * n) = w;
                        }
                    }
                s += shfl_x(s, lane, 16); s += shfl_x(s, lane, 32); ss += shfl_x(ss, lane, 16); ss += shfl_x(ss, lane, 32);
                if (fq == 0) *(f32x2*)(stats_new + (size_t)r * 32 + (u.pn * 4 + wc) * 2) = (f32x2){s, ss};
            }
        if (fin) {
            asm volatile("s_waitcnt vmcnt(0)" ::: "memory");
            __builtin_amdgcn_s_barrier();
            if (wr == 0 && wc == 0 && lane == 0) {
                __builtin_amdgcn_fence(__ATOMIC_RELEASE, "agent");
                asm volatile("s_waitcnt vmcnt(0)" ::: "memory");
                __hip_atomic_fetch_add(cnt + 4 * u.pm, 1u, __ATOMIC_RELAXED, __HIP_MEMORY_SCOPE_AGENT);
                unsigned sp = 0;
                while (__hip_atomic_load(cnt + 4 * u.pm, __ATOMIC_RELAXED, __HIP_MEMORY_SCOPE_AGENT) < 4u) { __builtin_amdgcn_s_sleep(1); if (++sp > (1u << 22)) break; }
                __builtin_amdgcn_fence(__ATOMIC_ACQUIRE, "agent");
                asm volatile("s_waitcnt vmcnt(0)" ::: "memory");
            }
            __builtin_amdgcn_s_barrier();
            asm volatile("" : "+v"(fr), "+v"(fq) :: "memory");
            const int lane2 = fr + 16 * fq, colf = u.pn * 256 + wc * 32 + 4 * fq;
            UnitStats sf; sf.load(stats_new, rowbase, lane2);
            f32x4 fgv[2][2], fbv[2][2];
#pragma unroll
            for (int bj = 0; bj < 2; ++bj)
#pragma unroll
                for (int n = 0; n < 2; ++n) { const LAS float* ct = ctab + 512 + wc * 32 + 4 * fq + 128 * bj + 16 * n; fgv[bj][n] = *(const LAS f32x4*)ct; fbv[bj][n] = *(const LAS f32x4*)(ct + 256); }
#pragma unroll
            for (int ai = 0; ai < 2; ++ai)
#pragma unroll
                for (int m = 0; m < 4; ++m) {
                    float mu, rs; sf.get(ai, m, fr, mu, rs);
                    const int r = rowbase + 128 * ai + 16 * m + fr;
                    float* orow = zf + (size_t)r * 1024 + colf;
#pragma unroll
                    for (int bj = 0; bj < 2; ++bj)
#pragma unroll
                        for (int n = 0; n < 2; ++n) {
                            const f32x4 gv = fgv[bj][n], bv = fbv[bj][n];
                            f32x4 o;
#pragma unroll
                            for (int j = 0; j < 4; ++j) o[j] = (acc[ai][bj][m][n][j] - mu) * rs * gv[j] + bv[j];
                            *(f32x4*)(orow + 128 * bj + 16 * n) = o;
                        }
                    asm volatile("" ::: "memory");
                }
        }
    }
    __device__ __forceinline__ void tail(int u, int row, int c, float p0, float p1, float q0, float q1) const {
        const int r = TM + row, n0 = (u >> 2) * 256 + (u & 3) * 32 + c;
        float mu, rs; load_row_stat(stats, r, mu, rs);
        bf16_t* br = (bf16_t*)(ws + OFF_ZB) + (size_t)r * 1024;
        const float acc4[4] = {p0, p1, q0, q1}; const int cols[4] = {n0, n0 + 1, n0 + 128, n0 + 129};
        float zn[4]; float s = 0.f, ss = 0.f;
#pragma unroll
        for (int k = 0; k < 4; ++k) { const float h = (bf2f(br[cols[k]]) - mu) * rs * lg[cols[k]] + lb[cols[k]]; zn[k] = ALPHA * h + bscale * acc4[k]; s += zn[k]; ss += zn[k] * zn[k]; }
        *(unsigned*)(br + n0) = cvt_pk_bf16(zn[0], zn[1]); *(unsigned*)(br + n0 + 128) = cvt_pk_bf16(zn[2], zn[3]);
        { const int ln = lane_id_v();
#pragma unroll
        for (int o = 1; o < 16; o <<= 1) { s += shfl_x(s, ln, o); ss += shfl_x(ss, ln, o); } }
        if ((c & 30) == 0) *(f32x2*)(stats_new + (size_t)r * 32 + u * 2) = (f32x2){s, ss};
    }
};

struct EpiIn {
    static constexpr bool PERM = true;
    const float* stats; const cfix_t* c1; const cfix_t* c2; unsigned char* ws; const LAS float* ctab;
    __device__ __forceinline__ void operator()(const f32x4 (&acc)[2][2][4][2], const pg8::Unit& u, int wr, int wc, int fr, int fq, const UnitStats& st, int ui) const {
        asm volatile("" : "+v"(fr), "+v"(fq));
        const int lane = fr + 16 * fq, rowbase = u.pm * 256 + wr * 64;
        const int n0 = u.pn * 256 + wc * 32 + 8 * fq, pn = u.pn;
        f32x4 k1[2][2], k2[2][2];
#pragma unroll
        for (int bj = 0; bj < 2; ++bj)
#pragma unroll
            for (int n = 0; n < 2; ++n) { const LAS float* ct = ctab + ui * 512 + 128 * bj + wc * 32 + 8 * fq + 4 * n; k1[bj][n] = *(const LAS f32x4*)ct; k2[bj][n] = *(const LAS f32x4*)(ct + 256); }
#define VAL(ai, bj, m, n, j) (rs * (acc[ai][bj][m][n][j] - mu * k1[bj][n][j]) + k2[bj][n][j])
        if (pn == 0 || pn >= 7) {
            bf16_t* dst; int ld, col; const bool act = pn >= 9;
            if (pn == 0) { dst = (bf16_t*)(ws + OFF_XP); ld = 256; col = wc * 32 + 8 * fq; } else if (pn <= 8) { dst = (bf16_t*)(ws + OFF_V); ld = 512; col = 256 * (pn - 7) + wc * 32 + 8 * fq; } else { dst = (bf16_t*)(ws + OFF_SG); ld = 512; col = 256 * (pn - 9) + wc * 32 + 8 * fq; }
#pragma unroll
            for (int ai = 0; ai < 2; ++ai)
#pragma unroll
                for (int m = 0; m < 4; ++m) {
                    float mu, rs; st.get(ai, m, fr, mu, rs);
                    const int r = rowbase + 128 * ai + 16 * m + fr;
#pragma unroll
                    for (int bj = 0; bj < 2; ++bj) {
                        float o[8];
#pragma unroll
                        for (int n = 0; n < 2; ++n)
#pragma unroll
                            for (int j = 0; j < 4; ++j) { const float v = VAL(ai, bj, m, n, j); o[4 * n + j] = act ? silu_f(v) : v; }
                        u32x4 w; w.x = cvt_pk_bf16(o[0], o[1]); w.y = cvt_pk_bf16(o[2], o[3]); w.z = cvt_pk_bf16(o[4], o[5]); w.w = cvt_pk_bf16(o[6], o[7]);
                        *(u32x4*)(dst + (size_t)r * ld + col + 128 * bj) = w;
                    }
                }
        } else if (pn <= 2) {
            const int col = 128 * (pn - 1) + wc * 32 + 8 * fq;
            bf16_t* U = (bf16_t*)(ws + OFF_U);
#pragma unroll
            for (int ai = 0; ai < 2; ++ai)
#pragma unroll
                for (int m = 0; m < 4; ++m) {
                    float mu, rs; st.get(ai, m, fr, mu, rs);
                    const int r = rowbase + 128 * ai + 16 * m + fr;
                    float o[8];
#pragma unroll
                    for (int n = 0; n < 2; ++n)
#pragma unroll
                        for (int j = 0; j < 4; ++j) o[4 * n + j] = VAL(ai, 0, m, n, j) * fast_sigmoid(VAL(ai, 1, m, n, j));
                    u32x4 w; w.x = cvt_pk_bf16(o[0], o[1]); w.y = cvt_pk_bf16(o[2], o[3]); w.z = cvt_pk_bf16(o[4], o[5]); w.w = cvt_pk_bf16(o[6], o[7]);
                    *(u32x4*)(U + (size_t)r * 256 + col) = w;
                }
        } else {
            const bool isk = pn >= 5;
            const int head = 2 * ((pn - 3) & 1) + (wc >> 1), d0 = 32 * (wc & 1) + 8 * fq;
            bf16_t* dst = (bf16_t*)(ws + (isk ? OFF_K : OFF_Q)); bf16_t* K2 = (bf16_t*)(ws + OFF_K2);
            const float* rope = (const float*)(ws + OFF_ROPE);
            const float scale = isk ? 0.08838834764831845f : 1.0f;
            const float lgam = log2_gamma(head);
            f32x4 csn[4];
            { const f32x4* cs0 = (const f32x4*)(rope + ((size_t)(((rowbase + fr) & 8191) + NMETA) * 64 + d0) * 2);
#pragma unroll
              for (int q = 0; q < 4; ++q) csn[q] = cs0[q]; }
#pragma unroll
            for (int ai = 0; ai < 2; ++ai)
#pragma unroll
                for (int m = 0; m < 4; ++m) {
                    float mu, rs; st.get(ai, m, fr, mu, rs);
                    const int r = rowbase + 128 * ai + 16 * m + fr;
                    const int ci = r & 63;
                    f32x4 cs[4];
#pragma unroll
                    for (int q = 0; q < 4; ++q) cs[q] = csn[q];
                    if (ai * 4 + m < 7) {
                        const int rn = rowbase + 128 * ((ai * 4 + m + 1) >> 2) + 16 * ((ai * 4 + m + 1) & 3) + fr;
                        const f32x4* csp = (const f32x4*)(rope + ((size_t)((rn & 8191) + NMETA) * 64 + d0) * 2);
#pragma unroll
                        for (int q = 0; q < 4; ++q) csn[q] = csp[q];
                    }
                    const size_t off = (size_t)r * 512 + head * 128 + d0;
                    float o1[8], o2[8];
#pragma unroll
                    for (int n = 0; n < 2; ++n) {
                        const f32x4 csA = cs[2 * n], csB = cs[2 * n + 1];
                        const float cc[4] = {csA.x, csA.z, csB.x, csB.z}, sn[4] = {csA.y, csA.w, csB.y, csB.w};
#pragma unroll
                        for (int j = 0; j < 4; ++j) { const float x1 = VAL(ai, 0, m, n, j), x2 = VAL(ai, 1, m, n, j);
                            o1[4 * n + j] = (x1 * cc[j] - x2 * sn[j]) * scale; o2[4 * n + j] = (x2 * cc[j] + x1 * sn[j]) * scale; }
                    }
                    {
                        u32x4 w1, w2; w1.x = cvt_pk_bf16(o1[0], o1[1]); w1.y = cvt_pk_bf16(o1[2], o1[3]); w1.z = cvt_pk_bf16(o1[4], o1[5]); w1.w = cvt_pk_bf16(o1[6], o1[7]);
                        w2.x = cvt_pk_bf16(o2[0], o2[1]); w2.y = cvt_pk_bf16(o2[2], o2[3]); w2.z = cvt_pk_bf16(o2[4], o2[5]); w2.w = cvt_pk_bf16(o2[6], o2[7]);
                        *(u32x4*)(dst + off) = w1; *(u32x4*)(dst + off + 64) = w2;
                    }
                }
        }
#undef VAL
    }
    __device__ __forceinline__ void tail(int u, int row, int c, float p0, float p1, float q0, float q1) const {
        bf16_t *XP = (bf16_t*)(ws + OFF_XP), *U = (bf16_t*)(ws + OFF_U), *Q = (bf16_t*)(ws + OFF_Q), *K = (bf16_t*)(ws + OFF_K), *K2 = (bf16_t*)(ws + OFF_K2), *V = (bf16_t*)(ws + OFF_V), *SG = (bf16_t*)(ws + OFF_SG);
        const float* rope = (const float*)(ws + OFF_ROPE);
        const int r = TM + row, pn = u >> 2, wc = u & 3, n0 = pn * 256 + wc * 32 + c;
        float mu, rs; load_row_stat(stats, r, mu, rs);
        const float a0 = rs * (p0 - mu * cfix2f(c1[n0])) + cfix2f(c2[n0]), a1 = rs * (p1 - mu * cfix2f(c1[n0 + 1])) + cfix2f(c2[n0 + 1]);
        const float b0 = rs * (q0 - mu * cfix2f(c1[n0 + 128])) + cfix2f(c2[n0 + 128]), b1 = rs * (q1 - mu * cfix2f(c1[n0 + 129])) + cfix2f(c2[n0 + 129]);
        if (pn == 0 || pn >= 7) {
            bf16_t* dst; int ld, col; const bool act = pn >= 9;
            if (pn == 0) { dst = XP; ld = 256; col = wc * 32 + c; } else if (pn <= 8) { dst = V; ld = 512; col = 256 * (pn - 7) + wc * 32 + c; } else { dst = SG; ld = 512; col = 256 * (pn - 9) + wc * 32 + c; }
            *(unsigned*)(dst + (size_t)r * ld + col) = act ? cvt_pk_bf16(silu_f(a0), silu_f(a1)) : cvt_pk_bf16(a0, a1);
            *(unsigned*)(dst + (size_t)r * ld + col + 128) = act ? cvt_pk_bf16(silu_f(b0), silu_f(b1)) : cvt_pk_bf16(b0, b1);
        } else if (pn <= 2) {
            *(unsigned*)(U + (size_t)r * 256 + 128 * (pn - 1) + wc * 32 + c) = cvt_pk_bf16(a0 * fast_sigmoid(b0), a1 * fast_sigmoid(b1));
        } else {
            const bool isk = pn >= 5;
            const int head = 2 * ((pn - 3) & 1) + (wc >> 1), d = 32 * (wc & 1) + c, t = row & 15, ci = 48 + t;
            const float scale = isk ? 0.08838834764831845f : 1.0f;
            const f32x4 cs = *(const f32x4*)(rope + ((size_t)t * 64 + d) * 2);
            const float o10 = (a0 * cs.x - b0 * cs.y) * scale, o20 = (b0 * cs.x + a0 * cs.y) * scale;
            const float o11 = (a1 * cs.z - b1 * cs.w) * scale, o21 = (b1 * cs.z + a1 * cs.w) * scale;
            bf16_t* dst = isk ? K : Q; const size_t off = (size_t)r * 512 + head * 128 + d;
            *(unsigned*)(dst + off) = cvt_pk_bf16(o10, o11); *(unsigned*)(dst + off + 64) = cvt_pk_bf16(o20, o21);
        }
    }
};

template <class Epi>
__device__ __forceinline__ void tail_units(unsigned char* smem, const bf16_t* At, const bf16_t* Bt, int K, int nunits, int c0, const Epi& E, const int tid, const int bid) {
    const int wid = tid >> 6, lane = tid & 63; constexpr int G = GRID;
    float* part = (float*)smem;
    const int kw = K / 8;
    for (int u = (bid - c0 + G) % G; u < nunits; u += G) {
        const int n0 = (u >> 2) * 256 + (u & 3) * 32;
        f32x16 acc0, acc1;
#pragma unroll
        for (int i = 0; i < 16; ++i) { acc0[i] = 0.f; acc1[i] = 0.f; }
        const bf16_t* ap = At + (size_t)(lane & 31) * K + wid * kw + 8 * (lane >> 5);
        const bf16_t* bp0 = Bt + (size_t)(n0 + (lane & 31)) * K + wid * kw + 8 * (lane >> 5);
        const bf16_t* bp1 = bp0 + (size_t)128 * K;
        for (int k0 = 0; k0 < kw; k0 += 176) {
            bf16x8 av[11], b0v[11], b1v[11];
#pragma unroll
            for (int j = 0; j < 11; ++j) if (k0 + 16 * j < kw) { av[j] = *(const bf16x8*)(ap + k0 + 16 * j); b0v[j] = *(const bf16x8*)(bp0 + k0 + 16 * j); b1v[j] = *(const bf16x8*)(bp1 + k0 + 16 * j); }
#pragma unroll
            for (int j = 0; j < 11; ++j) if (k0 + 16 * j < kw) {
                acc0 = __builtin_amdgcn_mfma_f32_32x32x16_bf16(av[j], b0v[j], acc0, 0, 0, 0);
                acc1 = __builtin_amdgcn_mfma_f32_32x32x16_bf16(av[j], b1v[j], acc1, 0, 0, 0);
            }
        }
#pragma unroll
        for (int i = 0; i < 16; ++i) { const int row = (i & 3) + 8 * (i >> 2) + 4 * (lane >> 5); part[wid * 2048 + row * 64 + (lane & 31)] = acc0[i]; part[wid * 2048 + row * 64 + 32 + (lane & 31)] = acc1[i]; }
        __syncthreads();
        const int row = tid >> 4, c = (tid & 15) * 2;
        float p0 = 0.f, p1 = 0.f, q0 = 0.f, q1 = 0.f;
#pragma unroll
        for (int w = 0; w < 8; ++w) { const float* pp = part + w * 2048 + row * 64 + c; p0 += pp[0]; p1 += pp[1]; q0 += pp[32]; q1 += pp[33]; }
        E.tail(u, row, c, p0, p1, q0, q1);
        __syncthreads();
    }
}


__device__ __forceinline__ bf16x8 tr_frag(const unsigned char* tile, int stride, int row0, int col0, int lane) {
    const int g = lane >> 4, q = (lane & 15) >> 2, p = lane & 3;
    const unsigned char* a0 = tile + (row0 + 4 * g + q) * stride + (col0 + 4 * p) * 2;
    const v4i16_t lo = __builtin_amdgcn_ds_read_tr16_b64_v4i16((LAS v4i16_t*)(a0));
    const v4i16_t hi = __builtin_amdgcn_ds_read_tr16_b64_v4i16((LAS v4i16_t*)(a0 + 16 * stride));
    bf16x8 r; r[0] = lo[0]; r[1] = lo[1]; r[2] = lo[2]; r[3] = lo[3]; r[4] = hi[0]; r[5] = hi[1]; r[6] = hi[2]; r[7] = hi[3];
    return r;
}
template <int NKS>
__device__ __forceinline__ void tile_gemm_loadB(bf16x8 (&bf)[NKS][2], const bf16_t* Bt, int ks_lo, int wave, int lane) {
    const bf16_t* bp = Bt + (size_t)(32 * wave + (lane & 15)) * 256 + 8 * (lane >> 4) + 32 * ks_lo;
#pragma unroll
    for (int ks = 0; ks < NKS; ++ks) { bf[ks][0] = *(const bf16x8*)(bp + 32 * ks); bf[ks][1] = *(const bf16x8*)(bp + 16 * 256 + 32 * ks); }
}
template <int NKS>
__device__ __forceinline__ void tile_gemm64(const unsigned char* At, int ast, const bf16x8 (&bf)[NKS][2], int ks_lo, int lane, f32x4 (&acc)[4][2]) {
#pragma unroll
    for (int mt = 0; mt < 4; ++mt) { acc[mt][0] = (f32x4){0.f, 0.f, 0.f, 0.f}; acc[mt][1] = (f32x4){0.f, 0.f, 0.f, 0.f}; }
    const unsigned char* ap = At + (lane & 15) * ast + 16 * (lane >> 4) + 64 * ks_lo;
#pragma unroll
    for (int ks = 0; ks < NKS; ++ks) {
#pragma unroll
        for (int mt = 0; mt < 4; ++mt) {
            const bf16x8 av = *(const bf16x8*)(ap + 16 * mt * ast + 64 * ks);
            acc[mt][0] = __builtin_amdgcn_mfma_f32_16x16x32_bf16(bf[ks][0], av, acc[mt][0], 0, 0, 0);
            acc[mt][1] = __builtin_amdgcn_mfma_f32_16x16x32_bf16(bf[ks][1], av, acc[mt][1], 0, 0, 0);
        }
    }
}
__device__ __forceinline__ void load_tok_tile(unsigned char* tile, const bf16_t* src, int b, int t0, int halo, int tid) {
    const int nchunk = (64 + halo) * 32;
    u32x4 v[6];
#pragma unroll
    for (int k = 0; k < 6; ++k) {
        const int idx = tid + 512 * k, row = idx >> 5, ch = idx & 31, t = t0 - halo + row;
        const bool ok = idx < nchunk && t >= 0 && t < LSEQ;
        const u32x4 ld = *(const u32x4*)(src + (size_t)tok_row(b, ok ? t : 0) * 256 + ch * 8);
        v[k] = ok ? ld : (u32x4){0u, 0u, 0u, 0u};
    }
#pragma unroll
    for (int k = 0; k < 6; ++k) { const int idx = tid + 512 * k, row = idx >> 5, ch = idx & 31; if (idx < nchunk) *(u32x4*)(tile + row * 512 + ch * 16) = v[k]; }
}
constexpr int ATS = 528;
constexpr int YS = 260;
constexpr int KTS = 272;
constexpr int LDS_AT = 49152, LDS_Y = 49152;

__device__ __forceinline__ void store_tile64(const f32x4 (&acc)[4][2], bf16_t* YC, int colbase, int b, int t0, int wave, int lane) {
#pragma unroll
    for (int mt = 0; mt < 4; ++mt) {
        const int t = t0 + 16 * mt + (lane & 15);
        if (t < LSEQ) {
            bf16_t* dst = YC + (size_t)tok_row(b, t) * 1024 + colbase + 32 * wave + 4 * (lane >> 4);
#pragma unroll
            for (int nt = 0; nt < 2; ++nt) { u32x2 w; w.x = cvt_pk_bf16(acc[mt][nt][0], acc[mt][nt][1]); w.y = cvt_pk_bf16(acc[mt][nt][2], acc[mt][nt][3]); *(u32x2*)(dst + 16 * nt) = w; }
        }
    }
}

__device__ __forceinline__ void pool_item(unsigned char* smem, const bf16_t* XP, const bf16_t* PPT, bf16_t* YC, int b, int tb, int tid) {
    const int t0 = 64 * tb, lane = tid & 63, wave = tid >> 6;
    load_tok_tile(smem, XP, b, t0, 15, tid);
    bf16x8 bfr[2][2]; tile_gemm_loadB<2>(bfr, PPT, 2 * (wave >> 1), wave, lane);
    __syncthreads();
    {
        const int c = tid & 255, i0 = (tid >> 8) * 32, gi = c >> 6, w = 2 << gi;
        const bf16_t* xt = (const bf16_t*)smem;
        float s = 0.f;
#pragma unroll 1
        for (int k = 1; k < w; ++k) s += bf2f(xt[(i0 + 15 - k) * 256 + c]);
        bf16_t* at = (bf16_t*)(smem + LDS_AT);
#pragma unroll 1
        for (int ib = i0; ib < i0 + 32; ib += 8) {
            unsigned short xa[8], xo[8];
#pragma unroll
            for (int q = 0; q < 8; ++q) { xa[q] = xt[(ib + q + 15) * 256 + c]; xo[q] = xt[(ib + q + 15 - (w - 1)) * 256 + c]; }
#pragma unroll
            for (int q = 0; q < 8; ++q) {
                const float xv = bf2f(xa[q]);
                s += xv;
                const int t = t0 + ib + q, cnt = (t + 1 < w) ? (t + 1) : w;
                at[(ib + q) * (ATS / 2) + c] = (bf16_t)f2bf(s * __builtin_amdgcn_rcpf((float)cnt) - xv);
                s -= bf2f(xo[q]);
            }
        }
    }
    __syncthreads();
    f32x4 acc[4][2];
    tile_gemm64<2>(smem + LDS_AT, ATS, bfr, 2 * (wave >> 1), lane, acc);
    store_tile64(acc, YC, 0, b, t0, wave, lane);
    __syncthreads();
}

__device__ __forceinline__ void conv_item(unsigned char* smem, const bf16_t* U, const bf16_t* PWT, const float* dw, const float* db, const float* lng, const float* lnb, bf16_t* YC, int b, int tb, int tid) {
    const int t0 = 64 * tb, lane = tid & 63, wave = tid >> 6;
    float w[31];
    {
        const int c = tid & 255;
#pragma unroll
        for (int j = 0; j < 31; ++j) w[j] = dw[j * 256 + c];
    }
    const float bias = db[tid & 255];
    load_tok_tile(smem, U, b, t0, 30, tid);
    __syncthreads();
    {
        const int c = tid & 255, i0 = (tid >> 8) * 32;
        const bf16_t* ut = (const bf16_t*)smem;
        float* Y = (float*)(smem + LDS_Y);
#pragma unroll 1
        for (int grp = 0; grp < 4; ++grp) {
            float a8[8];
#pragma unroll
            for (int i = 0; i < 8; ++i) a8[i] = bias;
            const bf16_t* up = ut + (i0 + grp * 8) * 256 + c;
#pragma unroll
            for (int jb = 0; jb < 40; jb += 8) {
                unsigned short raw[8];
#pragma unroll
                for (int q = 0; q < 8; ++q) raw[q] = (jb + q < 38) ? up[(jb + q) * 256] : (unsigned short)0;
#pragma unroll
                for (int q = 0; q < 8; ++q) {
                    const int jj = jb + q; const float v = bf2f(raw[q]);
#pragma unroll
                    for (int i = 0; i < 8; ++i) if (jj < 38 && jj - i >= 0 && jj - i <= 30) a8[i] += w[jj - i] * v;
                }
            }
#pragma unroll
            for (int i = 0; i < 8; ++i) Y[(i0 + grp * 8 + i) * YS + c] = a8[i];
        }
    }
    __syncthreads();
    bf16x8 bfr[8][2]; tile_gemm_loadB<8>(bfr, PWT, 0, wave, lane);
    {
        const float* Y = (const float*)(smem + LDS_Y);
        const f32x4 gg = *(const f32x4*)(lng + 4 * lane), bb = *(const f32x4*)(lnb + 4 * lane);
#pragma unroll 2
        for (int k = 0; k < 8; ++k) {
            const int tok = 8 * wave + k;
            f32x4 y = *(const f32x4*)(Y + tok * YS + 4 * lane);
            float s1 = (y.x + y.y) + (y.z + y.w), s2 = (y.x * y.x + y.y * y.y) + (y.z * y.z + y.w * y.w);
#pragma unroll
            for (int o = 1; o < 64; o <<= 1) { s1 += shfl_x(s1, lane, o); s2 += shfl_x(s2, lane, o); }
            const float mean = s1 * (1.f / 256.f);
            const float rstd = rsqrtf(fmaxf(s2 * (1.f / 256.f) - mean * mean, 0.f) + LN_EPS);
            y = y - mean;
            const f32x4 n = y * rstd * gg + bb;
            u32x2 pk; pk.x = cvt_pk_bf16(silu_f(n.x), silu_f(n.y)); pk.y = cvt_pk_bf16(silu_f(n.z), silu_f(n.w));
            *(u32x2*)(smem + tok * ATS + 8 * lane) = pk;
        }
    }
    __syncthreads();
    f32x4 acc[4][2];
    tile_gemm64<8>(smem, ATS, bfr, 0, lane, acc);
    store_tile64(acc, YC, 256, b, t0, wave, lane);
    __syncthreads();
}

__device__ __forceinline__ int chunk_row(int b, int n, int p) { return n == 0 ? (p >= 48 ? TM + 16 * b + p - 48 : -1) : SEQ * b + 64 * (n - 1) + p; }
__device__ __forceinline__ void chunk_tile_load(u32x4 (&v)[2], const bf16_t* src, int b, int n, int h, int tid) {
#pragma unroll
    for (int k = 0; k < 2; ++k) {
        const int idx = tid + 512 * k, p = idx >> 4, ch = idx & 15, row = chunk_row(b, n, p);
        const u32x4 ld = *(const u32x4*)(src + (size_t)(row >= 0 ? row : 0) * 512 + h * 128 + ch * 8);
        v[k] = row >= 0 ? ld : (u32x4){0u, 0u, 0u, 0u};
    }
}
__device__ __forceinline__ void chunk_tile_store(unsigned char* tile, const u32x4 (&v)[2], int tid) {
#pragma unroll
    for (int k = 0; k < 2; ++k) { const int idx = tid + 512 * k, p = idx >> 4, ch = idx & 15; *(u32x4*)(tile + p * KTS + ch * 16) = v[k]; }
}
template <int NP>
__device__ __forceinline__ void kv_item(unsigned char* smem, const bf16_t* K2, const bf16_t* V, bf16_t* ST, int bh, int n, int tid) {
    const int lane = tid & 63, wave = tid >> 6, b = bh >> 2, h = bh & 3;
    {
        u32x4 vk[NP][2], vv[NP][2];
#pragma unroll
        for (int c = 0; c < NP; ++c) { chunk_tile_load(vk[c], K2, b, n + c, h, tid); chunk_tile_load(vv[c], V, b, n + c, h, tid); }
        {
            const float lgam = log2_gamma(h);
#pragma unroll
            for (int c = 0; c < NP; ++c)
#pragma unroll
                for (int k2 = 0; k2 < 2; ++k2) {
                    const float dec = __builtin_amdgcn_exp2f(lgam * (float)(63 - ((tid + 512 * k2) >> 4)));
                    u32x4 q = vk[c][k2];
                    q.x = cvt_pk_bf16(bf2f(q.x & 0xffffu) * dec, bf2f(q.x >> 16) * dec); q.y = cvt_pk_bf16(bf2f(q.y & 0xffffu) * dec, bf2f(q.y >> 16) * dec);
                    q.z = cvt_pk_bf16(bf2f(q.z & 0xffffu) * dec, bf2f(q.z >> 16) * dec); q.w = cvt_pk_bf16(bf2f(q.w & 0xffffu) * dec, bf2f(q.w >> 16) * dec);
                    vk[c][k2] = q;
                }
        }
#pragma unroll
        for (int c = 0; c < NP; ++c) { chunk_tile_store(smem + c * 128 * KTS, vk[c], tid); chunk_tile_store(smem + c * 128 * KTS + 64 * KTS, vv[c], tid); }
    }
    __syncthreads();
    const int dt0 = 2 * (wave & 3), et0 = 4 * (wave >> 2);
#pragma unroll
    for (int c = 0; c < NP; ++c) {
        const unsigned char* kt = smem + c * 128 * KTS;
        f32x4 acc[2][4];
#pragma unroll
        for (int dt = 0; dt < 2; ++dt)
#pragma unroll
            for (int et = 0; et < 4; ++et) acc[dt][et] = (f32x4){0.f, 0.f, 0.f, 0.f};
#pragma unroll
        for (int ks = 0; ks < 2; ++ks) {
            bf16x8 af[2], bfr[4];
#pragma unroll
            for (int dt = 0; dt < 2; ++dt) af[dt] = tr_frag(kt, KTS, 32 * ks, 16 * (dt0 + dt), lane);
#pragma unroll
            for (int et = 0; et < 4; ++et) bfr[et] = tr_frag(kt + 64 * KTS, KTS, 32 * ks, 16 * (et0 + et), lane);
#pragma unroll
            for (int dt = 0; dt < 2; ++dt)
#pragma unroll
                for (int et = 0; et < 4; ++et) acc[dt][et] = __builtin_amdgcn_mfma_f32_16x16x32_bf16(af[dt], bfr[et], acc[dt][et], 0, 0, 0);
        }
        bf16_t* dst = ST + ((size_t)(bh * NCHUNK + n + c)) * 16384;
#pragma unroll
        for (int dt = 0; dt < 2; ++dt)
#pragma unroll
            for (int et = 0; et < 4; ++et) { u32x2 w; w.x = cvt_pk_bf16(acc[dt][et][0], acc[dt][et][1]); w.y = cvt_pk_bf16(acc[dt][et][2], acc[dt][et][3]);
                *(u32x2*)(dst + (16 * (et0 + et) + (lane & 15)) * 128 + 16 * (dt0 + dt) + 4 * (lane >> 4)) = w; }
    }
    __syncthreads();
}

struct RetRegs { u32x4 vk[2], vv[2], vs[4]; bf16x8 qf[4]; u32x4 sg[2]; };
__device__ __forceinline__ void ret_load(RetRegs& R, const bf16_t* Q, const bf16_t* Kb, const bf16_t* V, const bf16_t* ST, const bf16_t* SG, int bh, int n, int tid) {
    const int lane = tid & 63, wave = tid >> 6, b = bh >> 2, h = bh & 3, g = lane >> 4, li = lane & 15, it = wave & 3, eh = wave >> 2;
    chunk_tile_load(R.vk, Kb, b, n, h, tid); chunk_tile_load(R.vv, V, b, n, h, tid);
    const bf16_t* sp = ST + ((size_t)(bh * NCHUNK + n)) * 16384;
#pragma unroll
    for (int k = 0; k < 4; ++k) { const int idx = tid + 512 * k, e = idx >> 4, ch = idx & 15; R.vs[k] = *(const u32x4*)(sp + e * 128 + ch * 8); }
    const int qrow = chunk_row(b, n, 16 * it + li);
#pragma unroll
    for (int ks = 0; ks < 4; ++ks) { const bf16x8 ld = *(const bf16x8*)(Q + (size_t)(qrow >= 0 ? qrow : 0) * 512 + h * 128 + 32 * ks + 8 * g); R.qf[ks] = qrow >= 0 ? ld : (bf16x8){0, 0, 0, 0, 0, 0, 0, 0}; }
#pragma unroll
    for (int k = 0; k < 2; ++k) {
        const int idx = tid + 512 * k, p = idx >> 4, ch = idx & 15, row = chunk_row(b, n, p);
        const u32x4 ld = *(const u32x4*)(SG + (size_t)(row >= 0 ? row : 0) * 512 + h * 128 + ch * 8);
        R.sg[k] = row >= 0 ? ld : (u32x4){0u, 0u, 0u, 0u};
    }
}
__device__ __forceinline__ void ret_item(unsigned char* smem, RetRegs& R, const bf16_t* Q, const bf16_t* Kb, const bf16_t* V, const bf16_t* ST, const bf16_t* SG, const float* gng, bf16_t* YC, int bh, int n, bool has_next, int nbh, int nn, int tid) {
    const int lane = tid & 63, wave = tid >> 6, b = bh >> 2, h = bh & 3, g = lane >> 4, li = lane & 15;
    unsigned char* KT = smem; unsigned char* VT = smem + 64 * KTS; unsigned char* STt = smem + 128 * KTS; float* PS = (float*)(smem + 256 * KTS);
    const int it = wave & 3, eh = wave >> 2;
    chunk_tile_store(KT, R.vk, tid); chunk_tile_store(VT, R.vv, tid);
#pragma unroll
    for (int k = 0; k < 4; ++k) { const int idx = tid + 512 * k, e = idx >> 4, ch = idx & 15; *(u32x4*)(STt + e * KTS + ch * 16) = R.vs[k]; }
    bf16x8 qf[4]; u32x4 sgc[2];
#pragma unroll
    for (int ks = 0; ks < 4; ++ks) qf[ks] = R.qf[ks];
    sgc[0] = R.sg[0]; sgc[1] = R.sg[1];
    __syncthreads();
    if (has_next) ret_load(R, Q, Kb, V, ST, SG, nbh, nn, tid);
    const float lgam = log2_gamma(h);
    float ggv[4];
#pragma unroll
    for (int et = 0; et < 4; ++et) ggv[et] = gng[h * 128 + 64 * eh + 16 * et + li];
    bf16x8 pf[2];
#pragma unroll
    for (int jt = 0; jt < 4; ++jt) {
        f32x4 sacc = (f32x4){0.f, 0.f, 0.f, 0.f};
#pragma unroll
        for (int ks = 0; ks < 4; ++ks) { const bf16x8 kf = *(const bf16x8*)(KT + (16 * jt + li) * KTS + 64 * ks + 16 * g); sacc = __builtin_amdgcn_mfma_f32_16x16x32_bf16(kf, qf[ks], sacc, 0, 0, 0); }
        const int i = 16 * it + li;
#pragma unroll
        for (int r = 0; r < 4; ++r) { const int j = 16 * jt + 4 * g + r, dist = i > j ? i - j : j - i; sacc[r] *= __builtin_amdgcn_exp2f(lgam * (float)dist); }
        const unsigned lo = cvt_pk_bf16(sacc[0], sacc[1]), hi = cvt_pk_bf16(sacc[2], sacc[3]);
        const int base = 4 * (jt & 1);
        pf[jt >> 1][base + 0] = (short)(lo & 0xffffu); pf[jt >> 1][base + 1] = (short)(lo >> 16); pf[jt >> 1][base + 2] = (short)(hi & 0xffffu); pf[jt >> 1][base + 3] = (short)(hi >> 16);
    }
    f32x4 o[4];
#pragma unroll
    for (int et = 0; et < 4; ++et) {
        const int e0 = 64 * eh + 16 * et;
        f32x4 a = (f32x4){0.f, 0.f, 0.f, 0.f};
#pragma unroll
        for (int ks = 0; ks < 4; ++ks) { const bf16x8 sf = *(const bf16x8*)(STt + (e0 + li) * KTS + 64 * ks + 16 * g); a = __builtin_amdgcn_mfma_f32_16x16x32_bf16(qf[ks], sf, a, 0, 0, 0); }
#pragma unroll
        for (int r = 0; r < 4; ++r) a[r] *= __builtin_amdgcn_exp2f(lgam * (float)(16 * it + 4 * g + r + 1));
#pragma unroll
        for (int ks = 0; ks < 2; ++ks) { const bf16x8 vf = tr_frag(VT, KTS, 32 * ks, e0, lane); a = __builtin_amdgcn_mfma_f32_16x16x32_bf16(pf[ks], vf, a, 0, 0, 0); }
        o[et] = a;
    }
    float ps[4], pss[4];
#pragma unroll
    for (int r = 0; r < 4; ++r) { float s1 = 0.f, s2 = 0.f;
#pragma unroll
        for (int et = 0; et < 4; ++et) { s1 += o[et][r]; s2 += o[et][r] * o[et][r]; }
#pragma unroll
        for (int m = 1; m < 16; m <<= 1) { s1 += shfl_x(s1, lane, m); s2 += shfl_x(s2, lane, m); }
        ps[r] = s1; pss[r] = s2; }
    if (li == 0) {
#pragma unroll
        for (int r = 0; r < 4; ++r) *(f32x2*)(PS + (eh * 64 + 16 * it + 4 * g + r) * 2) = (f32x2){ps[r], pss[r]};
    }
    __syncthreads();
#pragma unroll
    for (int r = 0; r < 4; ++r) {
        const int p = 16 * it + 4 * g + r, row = chunk_row(b, n, p);
        const f32x2 oth = *(const f32x2*)(PS + ((eh ^ 1) * 64 + p) * 2);
        const float mean = (ps[r] + oth.x) * (1.f / 128.f);
        const float var = (pss[r] + oth.y) * (1.f / 128.f) - mean * mean;
        const float rstd = rsqrtf(fmaxf(var, 0.f) + LN_EPS);
        {
#pragma unroll
            for (int et = 0; et < 4; ++et) ((bf16_t*)KT)[p * (KTS / 2) + 64 * eh + 16 * et + li] = (bf16_t)f2bf((o[et][r] - mean) * rstd * ggv[et]);
        }
    }
    __syncthreads();
#pragma unroll
    for (int k = 0; k < 2; ++k) {
        const int idx = tid + 512 * k, p = idx >> 4, ch = idx & 15, row = chunk_row(b, n, p);
        const u32x4 y = *(const u32x4*)(KT + p * KTS + ch * 16), q = sgc[k];
        u32x4 w;
        w.x = cvt_pk_bf16(bf2f(y.x & 0xffffu) * bf2f(q.x & 0xffffu), bf2f(y.x >> 16) * bf2f(q.x >> 16));
        w.y = cvt_pk_bf16(bf2f(y.y & 0xffffu) * bf2f(q.y & 0xffffu), bf2f(y.y >> 16) * bf2f(q.y >> 16));
        w.z = cvt_pk_bf16(bf2f(y.z & 0xffffu) * bf2f(q.z & 0xffffu), bf2f(y.z >> 16) * bf2f(q.z >> 16));
        w.w = cvt_pk_bf16(bf2f(y.w & 0xffffu) * bf2f(q.w & 0xffffu), bf2f(y.w >> 16) * bf2f(q.w >> 16));
        if (row >= 0) *(u32x4*)(YC + (size_t)row * 1024 + 512 + h * 128 + ch * 8) = w;
    }
    __syncthreads();
}

#define XB_TMO      128
#define XB_XCNT(j)  (256  + 64 * (j))
#define XB_XSUB(j)  (1280 + 64 * (j))
#define XB_XGEN(j)  (2304 + 64 * (j))
#define XB_TOP      3328
#define XB_TOPGEN   3392
#define XCD_BAR_WORDS 3456
#define XB_SPIN_CAP (1u << 22)
__device__ __forceinline__ unsigned xb_ld(unsigned* p)              { return __hip_atomic_load(p, __ATOMIC_RELAXED, __HIP_MEMORY_SCOPE_AGENT); }
__device__ __forceinline__ unsigned xb_add(unsigned* p, unsigned v) { return __hip_atomic_fetch_add(p, v, __ATOMIC_RELAXED, __HIP_MEMORY_SCOPE_AGENT); }
__device__ __forceinline__ unsigned xb_xcc_id() { return (unsigned)__builtin_amdgcn_s_getreg((3 << 11) | 20) & 0xFu; }
#define XB_SPIN(cond, bar) do { unsigned _sp = 0; while (cond) { __builtin_amdgcn_s_sleep(1); \
    if ((++_sp & 255u) == 0u) { if (xb_ld(&(bar)[XB_TMO])) break; if (_sp > XB_SPIN_CAP) { atomicAdd(&(bar)[XB_TMO], 1u); break; } } } } while (0)
struct XcdBarrier { unsigned* bar; unsigned x; volatile LAS unsigned* st; };
__device__ __forceinline__ XcdBarrier xcd_barrier_post(unsigned* bar, volatile LAS unsigned* st) {
    XcdBarrier b; b.bar = bar; b.x = xb_xcc_id(); b.st = st;
    if (threadIdx.x == 0) (void)xb_add(&bar[XB_XCNT(b.x)], 1u);
    return b;
}
__device__ __forceinline__ void xcd_barrier_complete(unsigned* bar, unsigned x, unsigned& nloc, unsigned& nx) {
    const unsigned G = gridDim.x * gridDim.y * gridDim.z;
    unsigned sum, cnt, mine, sp = 0u;
    for (;;) {
        sum = 0u; cnt = 0u; mine = 0u;
#pragma unroll
        for (unsigned j = 0; j < 16; ++j) { const unsigned c = xb_ld(&bar[XB_XCNT(j)]); sum += c; cnt += (c > 0u) ? 1u : 0u; mine = (j == x) ? c : mine; }
        if (sum == G) break;
        __builtin_amdgcn_s_sleep(1);
        if ((++sp & 255u) == 0u) { if (xb_ld(&bar[XB_TMO])) break; if (sp > XB_SPIN_CAP) { atomicAdd(&bar[XB_TMO], 1u); break; } }
    }
    nloc = mine > 0u ? mine : 1u; nx = cnt > 0u ? cnt : 1u;
}
__device__ __forceinline__ void xcd_barrier(const XcdBarrier& b, const int wave_s) {
    asm volatile("s_waitcnt vmcnt(0)" ::: "memory");
    __syncthreads();
    if (wave_s == 0 && lane_id_v() == 0) {
        unsigned* bar = b.bar;
        asm volatile("" : "+s"(bar));
        __builtin_amdgcn_s_waitcnt(0);
        unsigned nloc = b.st[0], nx = b.st[1];
        if (nloc == 0u) { xcd_barrier_complete(bar, b.x, nloc, nx); b.st[0] = nloc; b.st[1] = nx; }
        const unsigned old = xb_add(&bar[XB_XSUB(b.x)], 1u);
        const unsigned gen = old / nloc;
        if (old + 1u == (gen + 1u) * nloc) {
            __builtin_amdgcn_fence(__ATOMIC_RELEASE, "agent");
            asm volatile("s_waitcnt vmcnt(0)" ::: "memory");
            const unsigned og = xb_add(&bar[XB_TOP], 1u);
            const unsigned tg = og / nx;
            if (og + 1u == (tg + 1u) * nx) xb_add(&bar[XB_TOPGEN], 1u);
            else XB_SPIN(xb_ld(&bar[XB_TOPGEN]) == tg, bar);
            __builtin_amdgcn_fence(__ATOMIC_ACQUIRE, "agent");
            xb_add(&bar[XB_XGEN(b.x)], 1u);
            asm volatile("s_waitcnt vmcnt(0)" ::: "memory");
        } else {
            XB_SPIN(xb_ld(&bar[XB_XGEN(b.x)]) == gen, bar);
            __builtin_amdgcn_fence(__ATOMIC_ACQUIRE, "agent");
            asm volatile("s_waitcnt vmcnt(0)" ::: "memory");
        }
    }
    __syncthreads();
}

__device__ __forceinline__ void cvt_item(const float* src, int K, int Nsrc, bf16_t* dst, int Kp, int Nd, int type, const float* g, const float* b, cfix_t* c1, cfix_t* c2, int item, float* scr, int lane) {
    const int nblk = Nd / 32, kb = item / nblk, nb = item % nblk, k0 = 64 * kb, n0 = 32 * nb;
    int sc = n0; bool valid = true;
    const int pn = n0 >> 8, bj = (n0 >> 7) & 1, cc = n0 & 127;
    if (type == 0) { const int gcol = 128 * pn + cc; valid = gcol < DFF; sc = bj ? DFF + gcol : gcol; }
    else if (type == 2) {
        if (pn == 0 || pn >= 7) sc = n0;
        else if (pn <= 2) sc = 256 + 256 * bj + 128 * (pn - 1) + cc;
        else { const int base = pn <= 4 ? 768 : 1280, head = 2 * ((pn - 3) & 1) + (cc >> 6); sc = base + 128 * head + 64 * bj + (cc & 63); }
    }
    float a1 = 0.f, a2 = 0.f;
    float vv[32];
#pragma unroll
    for (int i = 0; i < 32; ++i) { const int k = k0 + 2 * i + (lane >> 5); vv[i] = (valid && k < K) ? src[(size_t)k * Nsrc + sc + (lane & 31)] : 0.f; }
#pragma unroll
    for (int i = 0; i < 32; ++i) {
        const int kk = 2 * i + (lane >> 5), k = k0 + kk;
        float v = vv[i];
        if (g) { a2 += b[k] * v; v *= g[k]; a1 += bf2f(f2bf(v)); }
        scr[kk * 33 + (lane & 31)] = v;
    }
    if (g) { a1 += shfl_x(a1, lane, 32); a2 += shfl_x(a2, lane, 32); if (lane < 32) { atomicAdd((unsigned long long*)(c1 + n0 + lane), (unsigned long long)(cfix_t)llrintf(a1 * 4294967296.0f)); atomicAdd((unsigned long long*)(c2 + n0 + lane), (unsigned long long)(cfix_t)llrintf(a2 * 4294967296.0f)); } }
    asm volatile("s_waitcnt lgkmcnt(0)" ::: "memory");
    const int c = lane & 7;
#pragma unroll
    for (int j = 0; j < 4; ++j) { const int n = (lane >> 3) + 8 * j; const float* s = scr + (8 * c) * 33 + n;
        u32x4 o; o.x = cvt_pk_bf16(s[0 * 33], s[1 * 33]); o.y = cvt_pk_bf16(s[2 * 33], s[3 * 33]); o.z = cvt_pk_bf16(s[4 * 33], s[5 * 33]); o.w = cvt_pk_bf16(s[6 * 33], s[7 * 33]);
        *(u32x4*)(dst + (size_t)(n0 + n) * Kp + k0 + 8 * c) = o; }
    asm volatile("s_waitcnt lgkmcnt(0)" ::: "memory");
}
__device__ __forceinline__ void cvt_job(const float* src, int K, int Nsrc, bf16_t* dst, int Kp, int Nd, int type, const float* g, const float* b, cfix_t* c1, cfix_t* c2, float* scr, int gw, int NGW, int lane) {
    const int nitems = (Kp / 64) * (Nd / 32);
    for (int it = gw; it < nitems; it += NGW) cvt_item(src, K, Nsrc, dst, Kp, Nd, type, g, b, c1, c2, it, scr, lane);
}

struct Args { const float* in[20]; float* out; unsigned char* ws; int ph_lo, ph_hi, use_cg, pad; };

#define INP(i) ((const float*)(((unsigned long long)(unsigned)__builtin_amdgcn_readfirstlane((int)ptab[2 * (i) + 1]) << 32) | (unsigned long long)(unsigned)__builtin_amdgcn_readfirstlane((int)ptab[2 * (i)])))
template <bool PRO, bool MID, int MASK>
__device__ __forceinline__ void run_phase(const Args& a, unsigned char* smem, volatile LAS unsigned* ptab_in, const int ph, const int G, const int NGW, const int NTH, const int wave_s) {
        unsigned pt_ = (unsigned)(unsigned long long)ptab_in; asm volatile("" : "+s"(pt_));
        volatile LAS unsigned* ptab = (volatile LAS unsigned*)(unsigned long long)pt_;
        unsigned char* ws = a.ws; float* zf = a.out;
        asm volatile("" : "+s"(ws), "+s"(zf));
        int bid = blockIdx.x;
        asm volatile("" : "+s"(bid));
        const int wave = wave_s;
#define TID_SETUP int tid = wave_s * 64 + lane_id_v(); const int lane = tid & 63, gw = bid * 8 + wave, gtid = bid * 512 + tid; (void)lane; (void)gw; (void)gtid;
        const float* x = INP(0); const float* meta = INP(1);
        float* zfm = (float*)(ws + OFF_ZFM);
        float* stats0 = (float*)(ws + OFF_STATS); float* stats1 = (float*)(ws + OFF_STATS + STATS_BYTES);
        float* rope = (float*)(ws + OFF_ROPE);
        cfix_t* cvec = (cfix_t*)(ws + OFF_CVEC);
        bf16_t* zb = (bf16_t*)(ws + OFF_ZB);
        bf16_t* Gb = (bf16_t*)(ws + OFF_G);
        bf16_t *XP = (bf16_t*)(ws + OFF_XP), *U = (bf16_t*)(ws + OFF_U), *Q = (bf16_t*)(ws + OFF_Q), *Kb = (bf16_t*)(ws + OFF_K), *K2 = (bf16_t*)(ws + OFF_K2), *V = (bf16_t*)(ws + OFF_V), *SG = (bf16_t*)(ws + OFF_SG);
        bf16_t* YC = (bf16_t*)(ws + OFF_YCAT); bf16_t* ST = (bf16_t*)(ws + OFF_ST);
        bf16_t* WA13 = (bf16_t*)(ws + OFF_WA); bf16_t* WA2 = (bf16_t*)(ws + OFF_WA + W13_BYTES);
        bf16_t* WB13 = (bf16_t*)(ws + OFF_WB); bf16_t* WB2 = (bf16_t*)(ws + OFF_WB + W13_BYTES);
        const float* ln_g = INP(18); const float* ln_b = INP(19);
        float* scr = (float*)(smem + wave * 8704);
        if (PRO && (MASK & 1) && ph == 0) {
            TID_SETUP
            cvt_job(INP(4), 1024, 2 * DFF, WA13, 1024, NUP, 0, INP(2), INP(3), cvec + 0, cvec + 5632, scr, gw, NGW, lane);
            cvt_job(INP(5), DFF, 1024, WA2, GW, 1024, 1, nullptr, nullptr, nullptr, nullptr, scr, gw, NGW, lane);
            for (int l = 0; l < 2; ++l) {
                cvt_job(INP(13) + (size_t)l * 65536, 256, 256, (bf16_t*)(ws + OFF_PW) + (size_t)l * 65536, 256, 256, 1, nullptr, nullptr, nullptr, nullptr, scr, gw, NGW, lane);
                bf16_t* ppt = (bf16_t*)(ws + OFF_PP) + (size_t)l * 65536; const float* pw = INP(7) + (size_t)l * 16384; const float* psc = INP(8) + l * 256;
                for (int idx = gtid; idx < 65536; idx += NTH) { const int n = idx >> 8, kk = idx & 255;
                    ppt[idx] = (bf16_t)((kk >> 6) == (n >> 6) ? f2bf(pw[(size_t)((n >> 6) * 64 + (kk & 63)) * 64 + (n & 63)] * psc[n]) : 0u); }
            }
            for (int r0 = gw; r0 < T; r0 += 2 * NGW) {
                const int r1 = r0 + NGW; const bool two = r1 < T; const int r1c = two ? r1 : r0;
                const float* s0 = r0 < TM ? x + (size_t)r0 * 1024 : meta + (size_t)((r0 - TM) & 15) * 1024;
                const float* s1 = r1c < TM ? x + (size_t)r1c * 1024 : meta + (size_t)((r1c - TM) & 15) * 1024;
                f32x4 v[4], w4[4]; float sa = 0.f, ssa = 0.f, sb = 0.f, ssb = 0.f;
#pragma unroll
                for (int j = 0; j < 4; ++j) { v[j] = ((const f32x4*)s0)[lane + 64 * j]; w4[j] = ((const f32x4*)s1)[lane + 64 * j]; }
#pragma unroll
                for (int j = 0; j < 4; ++j) { sa += (v[j].x + v[j].y) + (v[j].z + v[j].w); ssa += (v[j].x * v[j].x + v[j].y * v[j].y) + (v[j].z * v[j].z + v[j].w * v[j].w);
                                              sb += (w4[j].x + w4[j].y) + (w4[j].z + w4[j].w); ssb += (w4[j].x * w4[j].x + w4[j].y * w4[j].y) + (w4[j].z * w4[j].z + w4[j].w * w4[j].w); }
#pragma unroll
                for (int o = 1; o < 64; o <<= 1) { sa += shfl_x(sa, lane, o); ssa += shfl_x(ssa, lane, o); sb += shfl_x(sb, lane, o); ssb += shfl_x(ssb, lane, o); }
#pragma unroll
                for (int j = 0; j < 4; ++j) { u32x2 w; w.x = cvt_pk_bf16(v[j].x, v[j].y); w.y = cvt_pk_bf16(v[j].z, v[j].w); ((u32x2*)(zb + (size_t)r0 * 1024))[lane + 64 * j] = w; }
                if (lane < 16) ((f32x2*)(stats0 + (size_t)r0 * 32))[lane] = lane == 0 ? (f32x2){sa, ssa} : (f32x2){0.f, 0.f};
                if (two) {
#pragma unroll
                    for (int j = 0; j < 4; ++j) { u32x2 w; w.x = cvt_pk_bf16(w4[j].x, w4[j].y); w.y = cvt_pk_bf16(w4[j].z, w4[j].w); ((u32x2*)(zb + (size_t)r1 * 1024))[lane + 64 * j] = w; }
                    if (lane < 16) ((f32x2*)(stats0 + (size_t)r1 * 32))[lane] = lane == 0 ? (f32x2){sb, ssb} : (f32x2){0.f, 0.f};
                }
            }
            for (int idx = gtid; idx < LSEQ * 64; idx += NTH) {
                const int t = idx >> 6, i = idx & 63;
                const double inv = exp2(-(double)i * (13.287712379549449 / 64.0));
                double sn, cs; sincos((double)t * inv, &sn, &cs);
                ((f32x2*)rope)[idx] = (f32x2){(float)cs, (float)sn};
            }
        } else if (PRO && (MASK & 1) && ph == -1) {
            TID_SETUP
            const float* fg = ln_g + 5 * 1024; const float* fb = ln_b + 5 * 1024;
            for (int r = gw; r < TM; r += NGW) {
                f32x4* p = (f32x4*)(zf + (size_t)r * 1024); f32x4 v[4]; float s = 0.f;
#pragma unroll
                for (int j = 0; j < 4; ++j) { v[j] = p[lane + 64 * j]; s += (v[j].x + v[j].y) + (v[j].z + v[j].w); }
                const float mean = wave_sum(s, lane) * (1.f / 1024.f); float s2 = 0.f;
#pragma unroll
                for (int j = 0; j < 4; ++j) { v[j] = v[j] - mean; s2 += (v[j].x * v[j].x + v[j].y * v[j].y) + (v[j].z * v[j].z + v[j].w * v[j].w); }
                const float rstd = rsqrtf(wave_sum(s2, lane) * (1.f / 1024.f) + LN_EPS);
#pragma unroll
                for (int j = 0; j < 4; ++j) { const f32x4 gg = ((const f32x4*)fg)[lane + 64 * j], bb = ((const f32x4*)fb)[lane + 64 * j]; p[lane + 64 * j] = v[j] * rstd * gg + bb; }
            }
        } else if (MID) {
            const int q = ph - 1, l = q / 9, k = q - 9 * l;
            const int par = (3 * l + (k > 1 ? 1 : 0) + (k > 6 ? 1 : 0)) & 1;
            const float* sprev = par ? stats1 : stats0; float* snew = par ? stats0 : stats1;
            cfix_t* cv = cvec + l * 28160;
            bf16_t* win = (bf16_t*)(ws + (l ? OFF_WIO1 : OFF_WIO0)); bf16_t* wout = (bf16_t*)(ws + (l ? OFF_WIO1 : OFF_WIO0) + WIN_BYTES);
            if ((MASK & 2) && (k == 0 || k == 7)) {
                TID_SETUP
                pg8::Gemm g{zb, k == 0 ? WA13 : WB13, 1024}; pg8::StaticOrder S; S.init(TM, NUP, G, bid);
                const LAS float* ctab = (const LAS float*)((LAS unsigned char*)smem + CTAB_OFF);
                {
                    const cfix_t* cc1 = cv + (k == 0 ? 0 : 16896); const cfix_t* cc2 = cv + (k == 0 ? 5632 : 22528);
                    for (int i = 0; i < 6; ++i) { pg8::Unit uu; if (!S.next(i, uu)) break;
                        ((LAS float*)ctab)[i * 512 + tid] = cfix2f((tid < 256 ? cc1 : cc2)[uu.pn * 256 + (tid & 255)]); }
                    __syncthreads();
                }
                EpiUp E{sprev, cv + (k == 0 ? 0 : 16896), cv + (k == 0 ? 5632 : 22528), ws, ctab};
                pg8::gemm_phase<EpiUp>((LAS unsigned char*)smem, g, S, E, tid);
                tail_units<EpiUp>(smem, zb + (size_t)TM * 1024, g.Bt, 1024, NUP / 64, S.nwg % G, E, wave_s * 64 + lane_id_v(), bid);
                if (bid >= 128 && (k == 0 || (l == 0 && k == 7))) {
                    const int gw2 = (bid - 128) * 8 + wave, NGW2 = 128 * 8; const int ln2 = lane_id_v();
                    if (k == 0) {
                        cvt_job(INP(16) + (size_t)l * 1024 * 2 * DFF, 1024, 2 * DFF, WB13, 1024, NUP, 0, ln_g + (3 * l + 1) * 1024, ln_b + (3 * l + 1) * 1024, cv + 16896, cv + 22528, scr, gw2, NGW2, ln2);
                        cvt_job(INP(17) + (size_t)l * DFF * 1024, DFF, 1024, WB2, GW, 1024, 1, nullptr, nullptr, nullptr, nullptr, scr, gw2, NGW2, ln2);
                        if (l == 0) {
                            cvt_job(INP(6), 1024, DIN, win, 1024, DIN, 2, ln_g, ln_b, cv + 11264, cv + 14080, scr, gw2, NGW2, ln2);
                            cvt_job(INP(15), 1024, 1024, wout, 1024, 1024, 1, nullptr, nullptr, nullptr, nullptr, scr, gw2, NGW2, ln2);
                        }
                    } else {
                        cvt_job(INP(4) + (size_t)1024 * 2 * DFF, 1024, 2 * DFF, WA13, 1024, NUP, 0, ln_g + 2 * 1024, ln_b + 2 * 1024, cvec + 28160 + 0, cvec + 28160 + 5632, scr, gw2, NGW2, ln2);
                        cvt_job(INP(5) + (size_t)DFF * 1024, DFF, 1024, WA2, GW, 1024, 1, nullptr, nullptr, nullptr, nullptr, scr, gw2, NGW2, ln2);
                    }
                }
            } else if ((MASK & 4) && (k == 1 || k == 6 || k == 8)) {
                TID_SETUP
                const bool isout = k == 6;
                const int lni = k == 1 ? (l == 0 ? -1 : 2) : (k == 6 ? 3 * l + 0 : 3 * l + 1);
                const float* lg = lni < 0 ? INP(2) : ln_g + lni * 1024; const float* lb = lni < 0 ? INP(3) : ln_b + lni * 1024;
                const bf16_t* Amat = isout ? YC : Gb; const int Kd = isout ? 1024 : GW;
                const bf16_t* Bt = isout ? wout : (k == 1 ? WA2 : WB2);
                pg8::Gemm g{Amat, Bt, Kd}; pg8::StaticOrder S; S.init(TM, 1024, G, bid);
                const LAS float* ctab = (const LAS float*)((LAS unsigned char*)smem + CTAB_OFF);
                {
                    pg8::Unit uu; if (S.next(0, uu)) { const int cc = uu.pn * 256 + (tid & 255);
                        ((LAS float*)ctab)[tid] = (tid < 256 ? lg : lb)[cc]; ((LAS float*)ctab)[512 + tid] = (tid < 256 ? ln_g + 5 * 1024 : ln_b + 5 * 1024)[cc]; }
                    __syncthreads();
                }
                EpiRes E{sprev, snew, lg, lb, zf, ws, isout ? 1.0f : 0.5f,
                         (l == 1 && k == 8) ? 1 : 0, ln_g + 5 * 1024, ln_b + 5 * 1024, (unsigned*)(ws + OFF_CTL + 14336), ctab};
                pg8::gemm_phase<EpiRes>((LAS unsigned char*)smem, g, S, E, tid);
                if (!E.fin) tail_units<EpiRes>(smem, Amat + (size_t)TM * Kd, Bt, Kd, 16, S.nwg % G, E, wave_s * 64 + lane_id_v(), bid);
            } else if ((MASK & 8) && k == 2) {
                TID_SETUP
                pg8::Gemm g{zb, win, 1024}; pg8::StaticOrder S; S.init(TM, DIN, G, bid);
                const LAS float* ctab = (const LAS float*)((LAS unsigned char*)smem + CTAB_OFF);
                {
                    const cfix_t* cc1 = cv + 11264; const cfix_t* cc2 = cv + 14080;
                    for (int i = 0; i < 3; ++i) { pg8::Unit uu; if (!S.next(i, uu)) break;
                        ((LAS float*)ctab)[i * 512 + tid] = cfix2f((tid < 256 ? cc1 : cc2)[uu.pn * 256 + (tid & 255)]); }
                    __syncthreads();
                }
                EpiIn E{sprev, cv + 11264, cv + 14080, ws, ctab};
                pg8::gemm_phase<EpiIn>((LAS unsigned char*)smem, g, S, E, tid);
                tail_units<EpiIn>(smem, zb + (size_t)TM * 1024, win, 1024, DIN / 64, S.nwg % G, E, wave_s * 64 + lane_id_v(), bid);
                if (l == 0 && bid >= 192) {
                    const int gw2 = (bid - 192) * 8 + wave, NGW2 = 64 * 8; const int ln2 = lane_id_v();
                    cvt_job(INP(6) + (size_t)1024 * DIN, 1024, DIN, (bf16_t*)(ws + OFF_WIO1), 1024, DIN, 2, ln_g + 3 * 1024, ln_b + 3 * 1024, cvec + 28160 + 11264, cvec + 28160 + 14080, scr, gw2, NGW2, ln2);
                    cvt_job(INP(15) + (size_t)1024 * 1024, 1024, 1024, (bf16_t*)(ws + OFF_WIO1 + WIN_BYTES), 1024, 1024, 1, nullptr, nullptr, nullptr, nullptr, scr, gw2, NGW2, ln2);
                }
            } else if ((MASK & 16) && k == 3) {
                TID_SETUP
                const bf16_t* PWT = (const bf16_t*)(ws + OFF_PW) + (size_t)l * 65536; const bf16_t* PPT = (const bf16_t*)(ws + OFF_PP) + (size_t)l * 65536;
                const float* dw = INP(9) + (size_t)l * 31 * 256; const float* db = INP(10) + l * 256;
                const float* cg_ = INP(11) + l * 256; const float* cb_ = INP(12) + l * 256;
                constexpr int NCV = 258, NPL = 258, NKV = 1024;
                for (int j = 0; j < 7; ++j) {
                    int it = -1; bool pair = false;
                    if (j == 0) it = bid;
                    else if (j == 1) { if (bid < 2) it = 256 + bid; }
                    else if (j == 2) it = NCV + bid;
                    else if (j == 3) { if (bid >= 2 && bid < 4) it = NCV + 256 + (bid - 2); }
                    else if (j < 6) { pair = true; if (bid >= 4) it = NCV + NPL + 4 * (bid - 4) + 2 * (j - 4); else if (bid >= 2 && j == 4) it = NCV + NPL + 1008 + 2 * (bid - 2); }
                    else { if (bid >= 4 && bid < 16) it = NCV + NPL + 1012 + (bid - 4); }
                    if (it < 0) continue;
                    asm volatile("" : "+v"(tid));
                    if (it < NCV) conv_item(smem, U, PWT, dw, db, cg_, cb_, YC, it / 129, it % 129, tid);
                    else if (it < NCV + NPL) pool_item(smem, XP, PPT, YC, (it - NCV) / 129, (it - NCV) % 129, tid);
                    else { const int kk = it - NCV - NPL; if (pair) kv_item<2>(smem, Kb, V, ST, kk >> 7, kk & 127, tid); else kv_item<1>(smem, Kb, V, ST, kk >> 7, kk & 127, tid); }
                }
            } else if ((MASK & 64) && k == 4) {
                TID_SETUP
                {
                    const int d = gtid & 127, e = (gtid >> 7) & 127, bh = gtid >> 14, h = bh & 3;
                    const float g64 = exp2f(64.f * log2_gamma(h));
                    bf16_t* p = ST + (size_t)bh * NCHUNK * 16384 + e * 128 + d;
                    float Sv = 0.f;
#pragma unroll 1
                    for (int n0 = 0; n0 < NCHUNK - 1; n0 += 32) {
                        unsigned short kvb[32];
#pragma unroll
                        for (int j = 0; j < 32; ++j) kvb[j] = p[(size_t)(n0 + j) * 16384];
#pragma unroll
                        for (int j = 0; j < 32; ++j) { p[(size_t)(n0 + j) * 16384] = (bf16_t)f2bf(Sv); Sv = g64 * Sv + bf2f(kvb[j]); }
                    }
                    p[(size_t)(NCHUNK - 1) * 16384] = (bf16_t)f2bf(Sv);
                }
            } else if ((MASK & 32) && k == 5) {
                TID_SETUP
                const float* gng = INP(14) + l * 512;
                RetRegs R;
                { const int bh0 = bid < 1024 ? (bid >> 7) : (bid - 1024), n0_ = bid < 1024 ? 1 + (bid & 127) : 0; ret_load(R, Q, Kb, V, ST, SG, bh0, n0_, tid); }
                for (int it = bid; it < 1032; it += G) {
                    const int bh = it < 1024 ? (it >> 7) : (it - 1024), n = it < 1024 ? 1 + (it & 127) : 0;
                    const int itn = it + G; const bool hn = itn < 1032;
                    const int nbh = itn < 1024 ? (itn >> 7) : (itn - 1024), nn = itn < 1024 ? 1 + (itn & 127) : 0;
                    ret_item(smem, R, Q, Kb, V, ST, SG, gng, YC, bh, n, hn, hn ? nbh : bh, hn ? nn : n, tid);
                }
            }
        }
}

template <int MASK>
__global__ void __launch_bounds__(512, 2) mk_fwd(Args a) {
    extern __shared__ __attribute__((aligned(16))) unsigned char smem[];
    constexpr int G = GRID, NGW = G * 8, NTH = G * 512;
    volatile LAS unsigned* misc = (volatile LAS unsigned*)((LAS unsigned char*)smem + MISC_OFF);
    if (threadIdx.x < 64) misc[threadIdx.x] = 0u;
    volatile LAS unsigned* ptab = misc + 64;
    if (threadIdx.x == 0) {
#pragma unroll
        for (int i = 0; i < 20; ++i) { const unsigned long long p = (unsigned long long)a.in[i]; ptab[2 * i] = (unsigned)p; ptab[2 * i + 1] = (unsigned)(p >> 32); }
    }
    __syncthreads();
    XcdBarrier bar = xcd_barrier_post((unsigned*)(a.ws + OFF_CTL), misc + 8);
    const int wave_s = __builtin_amdgcn_readfirstlane((int)(threadIdx.x >> 6));
    if (a.ph_lo <= 0 && a.ph_hi > 0) {
        run_phase<true, false, MASK>(a, smem, ptab, 0, G, NGW, NTH, wave_s);
        if (a.ph_hi > 1) { if (a.use_cg) cg::this_grid().sync(); else xcd_barrier(bar, wave_s); }
    }
    for (int ph = (a.ph_lo > 1 ? a.ph_lo : 1); ph < (a.ph_hi < NPH ? a.ph_hi : NPH); ++ph) {
        if (ph > 1 && ph > a.ph_lo) xcd_barrier(bar, wave_s);
        run_phase<false, true, MASK>(a, smem, ptab, ph, G, NGW, NTH, wave_s);
    }
}

template <int MASK> static void launch_plain(const Args& a, int grid, hipStream_t stream) {
    static bool attr = false;
    if (!attr) { (void)hipFuncSetAttribute((const void*)mk_fwd<MASK>, hipFuncAttributeMaxDynamicSharedMemorySize, LDS_BYTES); attr = true; }
    hipLaunchKernelGGL(mk_fwd<MASK>, dim3(grid), dim3(512), LDS_BYTES, stream, a);
}
extern "C" void kernel_launch(void* const* d_in, const int* in_sizes, int n_in, void* d_out, int out_size, void* d_ws, size_t ws_size, hipStream_t stream) {
    static int grid = 0;
    if (grid == 0) {
        if (n_in != 20 || out_size != TM * D || ws_size < WS_END) { fprintf(stderr, "kernel_launch: unexpected shapes (n_in %d, out %d, ws %zu, need %zu)\n", n_in, out_size, ws_size, (size_t)WS_END); grid = -1; return; }
        int dev = 0, cus = 0;
        (void)hipGetDevice(&dev); (void)hipDeviceGetAttribute(&cus, hipDeviceAttributeMultiprocessorCount, dev);
#if ONE_LAUNCH
        if (hipFuncSetAttribute((const void*)mk_fwd<127>, hipFuncAttributeMaxDynamicSharedMemorySize, LDS_BYTES) != hipSuccess) { fprintf(stderr, "kernel_launch: hipFuncSetAttribute failed\n"); grid = -1; return; }
#endif
        grid = GRID;
        if (cus != GRID) fprintf(stderr, "kernel_launch: warning: %d CUs, kernel built for %d\n", cus, GRID);
    }
    if (grid < 0) return;
    (void)hipMemsetAsync(d_ws, 0, ZERO_BYTES, stream);
    Args a{};
    for (int i = 0; i < 20; ++i) a.in[i] = (const float*)d_in[i];
    a.out = (float*)d_out; a.ws = (unsigned char*)d_ws; a.use_cg = 0; a.pad = 0;
#if ONE_LAUNCH
    a.ph_lo = 0; a.ph_hi = NPH;
    void* args[] = {&a};
    hipError_t e = hipLaunchCooperativeKernel((const void*)mk_fwd<127>, dim3(grid), dim3(512), args, LDS_BYTES, stream);
    if (e != hipSuccess) fprintf(stderr, "cooperative launch failed: %s (grid %d)\n", hipGetErrorString(e), grid);
#if PROBE_SET
    {
        static bool attr = false;
        if (!attr) { (void)hipFuncSetAttribute((const void*)mk_fwd<127>, hipFuncAttributeMaxDynamicSharedMemorySize, LDS_BYTES); attr = true; }
        for (int ph = 1; ph < NPH; ++ph) {
            const int k = (ph - 1) % 9;
            const bool sel = PROBE_SET == 1 ? (k == 0 || k == 7 || k == 2) : PROBE_SET == 2 ? (k == 3 || k == 4 || k == 5) : PROBE_SET == 3 ? (k == 0 || k == 7) : PROBE_SET == 4 ? (k == 3) : PROBE_SET == 5 ? (k == 4) : (k == 5);
            if (!sel) continue;
            a.ph_lo = ph; a.ph_hi = ph + 1;
            hipLaunchKernelGGL(mk_fwd<127>, dim3(grid), dim3(512), LDS_BYTES, stream, a);
        }
    }
#endif
#else
    for (int ph = 0; ph < NPH; ++ph) {
        a.ph_lo = ph; a.ph_hi = ph + 1;
        if (ph == 0) { launch_plain<1>(a, grid, stream); continue; }
        const int k = (ph - 1) % 9;
        if (k == 0 || k == 7) launch_plain<2>(a, grid, stream);
        else if (k == 1 || k == 6 || k == 8) launch_plain<4>(a, grid, stream);
        else if (k == 2) launch_plain<8>(a, grid, stream);
        else if (k == 3) launch_plain<16>(a, grid, stream);
        else if (k == 4) launch_plain<64>(a, grid, stream);
        else launch_plain<32>(a, grid, stream);
    }
#endif
}
```

```cpp
#include <hip/hip_runtime.h>
#include <hip/hip_cooperative_groups.h>
#include <cstdio>
#include <cstdint>
namespace cg = cooperative_groups;

#define LAS __attribute__((address_space(3)))
typedef unsigned short bf16_t;
typedef short bf16x8 __attribute__((ext_vector_type(8)));
typedef float f32x4 __attribute__((ext_vector_type(4)));
typedef float f32x16 __attribute__((ext_vector_type(16)));
typedef float f32x2 __attribute__((ext_vector_type(2)));
typedef unsigned u32x4 __attribute__((ext_vector_type(4)));
typedef unsigned u32x2 __attribute__((ext_vector_type(2)));

#ifndef EN_PRO
#define EN_PRO 1
#endif
#ifndef EN_UP
#define EN_UP 1
#endif
#ifndef EN_RES
#define EN_RES 1
#endif
#ifndef EN_IN
#define EN_IN 1
#endif
#ifndef EN_M1
#define EN_M1 1
#endif
#ifndef EN_M2
#define EN_M2 1
#endif
#ifndef PROBE_SET
#define PROBE_SET 0
#endif
#ifndef ONE_LAUNCH
#define ONE_LAUNCH 1
#endif

constexpr int D = 1024, SEQ = 8192, NMETA = 16, LSEQ = SEQ + NMETA, NB = 2;
constexpr int TM = NB * SEQ;
constexpr int T = TM + NB * NMETA;
constexpr int DFF = 2752, GW = 2816, NUP = 5632, DIN = 2816;
constexpr int NCHUNK = 129;
constexpr float ALPHA = 1.41421356237309515f;
constexpr float LN_EPS = 1e-5f;
constexpr int NPH = 19;
constexpr int GRID = 256;

constexpr size_t OFF_CTL = 0;
constexpr size_t OFF_CVEC = 16384;
constexpr size_t ZERO_BYTES = 524288;
constexpr size_t OFF_ZFM = 524288;
constexpr size_t OFF_STATS = OFF_ZFM + 32 * 1024 * 4;
constexpr size_t STATS_BYTES = (size_t)T * 32 * 4;
constexpr size_t OFF_ROPE = OFF_STATS + 2 * STATS_BYTES;
constexpr size_t OFF_PW = OFF_ROPE + (size_t)LSEQ * 64 * 8;
constexpr size_t OFF_PP = OFF_PW + 2 * 131072;
constexpr size_t OFF_WA = OFF_PP + 2 * 131072;
constexpr size_t W13_BYTES = (size_t)NUP * 1024 * 2, W2_BYTES = (size_t)1024 * GW * 2;
constexpr size_t OFF_WB = OFF_WA + W13_BYTES + W2_BYTES;
constexpr size_t OFF_WIO0 = OFF_WB + W13_BYTES + W2_BYTES;
constexpr size_t WIN_BYTES = (size_t)DIN * 1024 * 2, WOUT_BYTES = (size_t)1024 * 1024 * 2;
constexpr size_t OFF_WIO1 = OFF_WIO0 + WIN_BYTES + WOUT_BYTES;
constexpr size_t OFF_ZB = OFF_WIO1 + WIN_BYTES + WOUT_BYTES;
constexpr size_t OFF_R = OFF_ZB + (size_t)T * 1024 * 2;
constexpr size_t OFF_G = OFF_R;
constexpr size_t OFF_XP = OFF_R;
constexpr size_t OFF_U = OFF_XP + (size_t)T * 256 * 2;
constexpr size_t OFF_Q = OFF_U + (size_t)T * 256 * 2;
constexpr size_t OFF_K = OFF_Q + (size_t)T * 512 * 2;
constexpr size_t OFF_K2 = OFF_K + (size_t)T * 512 * 2;
constexpr size_t OFF_V = OFF_K2 + (size_t)T * 512 * 2;
constexpr size_t OFF_SG = OFF_V + (size_t)T * 512 * 2;
constexpr size_t OFF_YCAT = OFF_SG + (size_t)T * 512 * 2;
constexpr size_t OFF_ST = OFF_YCAT + (size_t)T * 1024 * 2;
constexpr size_t WS_END = OFF_ST + (size_t)NB * 4 * NCHUNK * 16384 * 2;
static_assert(OFF_G + (size_t)T * GW * 2 <= WS_END, "G fits");
static_assert(WS_END <= (size_t)268435456, "workspace budget");

constexpr int LDS_BYTES = 147456;
constexpr int MISC_OFF = 131072;
constexpr int CTAB_OFF = MISC_OFF + 1024;
typedef short v4i16_t __attribute__((ext_vector_type(4)));

__device__ __forceinline__ unsigned f2bf(float f) { unsigned u = __float_as_uint(f); return (u + 0x7fffu + ((u >> 16) & 1u)) >> 16; }
__device__ __forceinline__ float bf2f(unsigned h) { return __uint_as_float(h << 16); }
typedef __bf16 bf16x2_t __attribute__((ext_vector_type(2)));
__device__ __forceinline__ unsigned cvt_pk_bf16(float lo, float hi) { const f32x2 v = {lo, hi}; const bf16x2_t r = __builtin_convertvector(v, bf16x2_t); return __builtin_bit_cast(unsigned, r); }
__device__ __forceinline__ int lane_id_v() { int l; asm volatile("v_mbcnt_lo_u32_b32 %0, -1, 0\n\tv_mbcnt_hi_u32_b32 %0, -1, %0" : "=v"(l)); return l; }
__device__ __forceinline__ float shfl_i(float v, int src) { return __builtin_bit_cast(float, __builtin_amdgcn_ds_bpermute(src << 2, __builtin_bit_cast(int, v))); }
__device__ __forceinline__ float shfl_x(float v, int lane, int m) { return shfl_i(v, lane ^ m); }
__device__ __forceinline__ float wave_sum(float v, int lane) {
#pragma unroll
    for (int o = 1; o < 64; o <<= 1) v += shfl_x(v, lane, o);
    return v;
}
typedef long long cfix_t;
__device__ __forceinline__ float cfix2f(cfix_t v) { return (float)((double)v * (1.0 / 4294967296.0)); }
__device__ __forceinline__ f32x4 ldc4(const cfix_t* p) { const u32x4 a = *(const u32x4*)p, b = *(const u32x4*)(p + 2);
    return (f32x4){cfix2f((cfix_t)(((unsigned long long)a.y << 32) | a.x)), cfix2f((cfix_t)(((unsigned long long)a.w << 32) | a.z)), cfix2f((cfix_t)(((unsigned long long)b.y << 32) | b.x)), cfix2f((cfix_t)(((unsigned long long)b.w << 32) | b.z))}; }
__device__ __forceinline__ float fast_sigmoid(float x) { return __builtin_amdgcn_rcpf(1.0f + __builtin_amdgcn_exp2f(-1.4426950408889634f * x)); }
__device__ __forceinline__ float silu_f(float x) { return x * fast_sigmoid(x); }
__device__ __forceinline__ int tok_row(int b, int t) { return t < NMETA ? TM + NMETA * b + t : SEQ * b + t - NMETA; }
__device__ __forceinline__ void row_bt(int r, int& b, int& t) { if (r < TM) { b = r >> 13; t = (r & 8191) + NMETA; } else { const int m = r - TM; b = m >> 4; t = m & 15; } }
__device__ __forceinline__ float log2_gamma(int h) { return __log2f(1.0f - exp2f(-5.0f - (float)h)); }
__device__ __forceinline__ void stat_finish(float s, float ss, float& mu, float& rs) { mu = s * (1.f / 1024.f); const float var = ss * (1.f / 1024.f) - mu * mu; rs = rsqrtf(fmaxf(var, 0.f) + LN_EPS); }
__device__ __forceinline__ void load_row_stat(const float* stats, int r, float& mu, float& rs) {
    const f32x4* p = (const f32x4*)(stats + (size_t)r * 32); float s = 0.f, ss = 0.f;
#pragma unroll
    for (int k = 0; k < 8; ++k) { const f32x4 v = p[k]; s += v.x + v.z; ss += v.y + v.w; }
    stat_finish(s, ss, mu, rs);
}

struct UnitStats {
    float mu0, rs0, mu1, rs1;
    __device__ __forceinline__ void load(const float* stats, int rowbase, int lane) { load_row_stat(stats, rowbase + lane, mu0, rs0); load_row_stat(stats, rowbase + 128 + lane, mu1, rs1); }
    __device__ __forceinline__ void get(int ai, int m, int fr, float& mu, float& rs) const { const int src = 16 * m + fr; mu = shfl_i(ai ? mu1 : mu0, src); rs = shfl_i(ai ? rs1 : rs0, src); }
};

namespace pg8 {
constexpr int BM = 256, BK = 64, HALF = 128, HTB = HALF * BK * 2, STAGE_BYTES = 8 * HTB, NXCD = 8, WGM = 4;
__host__ __device__ __forceinline__ int lds_byte(int r, int c) { const int st = (r >> 4) * 2 + (c >> 5), rr = r & 15, cc = c & 31, ob = rr * 64 + cc * 2; return st * 1024 + (ob ^ (((ob >> 9) & 1) << 5)); }
__host__ __device__ __forceinline__ void stage_rc(int b, int& R, int& C) { const int st = b / 1024, sb = b % 1024, swz = sb ^ (((sb >> 9) & 1) << 5); R = (st >> 1) * 16 + swz / 64; C = (st & 1) * 32 + (swz % 64) / 2; }
__host__ __device__ __forceinline__ int perm32(int rho) { const int n = rho >> 4, i = rho & 15; return 8 * (i >> 2) + 4 * n + (i & 3); }
struct Unit { int pm, pn; };
struct Gemm { const bf16_t* A; const bf16_t* Bt; int K; };
struct StaticOrder {
    int nM, nN, nwg, G, c;
    __device__ void init(int M, int N, int G_, int c_) { nM = M / BM; nN = N / BM; nwg = nM * nN; G = G_; c = c_; }
    __device__ bool next(int i, Unit& u) const {
        const long L = (long)i * G + c; if (L >= nwg) return false;
        int wgid = (int)L; { const int q = nwg / NXCD, r = nwg % NXCD, xcd = wgid % NXCD, off = wgid / NXCD; wgid = (xcd < r ? xcd * (q + 1) : r * (q + 1) + (xcd - r) * q) + off; }
        const int nig = WGM * nN, gid = wgid / nig, fm = gid * WGM, gsz = (nM - fm) < WGM ? (nM - fm) : WGM;
        u.pm = __builtin_amdgcn_readfirstlane(fm + ((wgid % nig) % gsz)); u.pn = __builtin_amdgcn_readfirstlane((wgid % nig) / gsz); return true;
    }
};

template <class Epi>
__device__ __forceinline__ void gemm_phase(LAS unsigned char* lds, const Gemm g, const StaticOrder& S, const Epi& E, const int tid) {
    const int wid = __builtin_amdgcn_readfirstlane(tid >> 6), lane = tid & 63, wr = wid >> 2, wc = wid & 3, fr = lane & 15, fq = lane >> 4;
    const int K = g.K, nt = K / BK;
    unsigned voffA[2], voffB[2];
#pragma unroll
    for (int i = 0; i < 2; ++i) { int R, C; stage_rc(tid * 16 + i * 8192, R, C); const int Rb = Epi::PERM ? ((R & ~31) + perm32(R & 31)) : R;
        voffA[i] = (unsigned)(R * K + C) * 2u; voffB[i] = (unsigned)(Rb * K + C) * 2u; }
    const size_t kstep = (size_t)(BK * 2);
    const size_t hstep = (size_t)HALF * K * 2;
    const size_t tstep = 2 * hstep;
    const unsigned ldsw = (unsigned)wid * 1024u;
    const int aoff = lds_byte(wr * 64 + fr, fq * 8), boff = lds_byte(wc * 32 + fr, fq * 8);
#define PG8_SA(b, h) (((b) * 2 + (h)) * HTB)
#define PG8_SB(b, h) ((4 + (b) * 2 + (h)) * HTB)
#define PG8_STAGE(bufoff, gbase, voff) do { _Pragma("unroll") for (int _i = 0; _i < 2; ++_i) \
        __builtin_amdgcn_global_load_lds((const unsigned*)((const char*)(gbase) + (voff)[_i]), (LAS unsigned*)(lds + (bufoff) + ldsw + _i * 8192), 16, 0, 0); } while (0)
#define PG8_LDA(dst, b, h) do { _Pragma("unroll") for (int m = 0; m < 4; ++m) _Pragma("unroll") for (int k = 0; k < 2; ++k) dst[m][k] = *(const LAS bf16x8*)(lds + PG8_SA(b, h) + aoff + m * 2048 + k * 1024); } while (0)
#define PG8_LDB(dst, b, h) do { _Pragma("unroll") for (int n = 0; n < 2; ++n) _Pragma("unroll") for (int k = 0; k < 2; ++k) dst[n][k] = *(const LAS bf16x8*)(lds + PG8_SB(b, h) + boff + n * 2048 + k * 1024); } while (0)
#define PG8_MMA(ai, bj, At, Bt) do { __builtin_amdgcn_s_setprio(1); _Pragma("unroll") for (int m = 0; m < 4; ++m) _Pragma("unroll") for (int n = 0; n < 2; ++n) _Pragma("unroll") for (int k = 0; k < 2; ++k) \
        acc[ai][bj][m][n] = __builtin_amdgcn_mfma_f32_16x16x32_bf16(Bt[n][k], At[m][k], acc[ai][bj][m][n], 0, 0, 0); __builtin_amdgcn_s_setprio(0); } while (0)
#define PG8_WAIT_V(n) asm volatile("s_waitcnt vmcnt(" #n ")" ::: "memory")
#define PG8_WAIT_L(n) asm volatile("s_waitcnt lgkmcnt(" #n ")" ::: "memory")
#define PG8_BAR __builtin_amdgcn_s_barrier()
#define PG8_SCHED __builtin_amdgcn_sched_barrier(0)
    Unit cur, nxt; int ui = 0;
    if (!S.next(0, cur)) return;
    UnitStats stn;
    stn.load(E.stats, cur.pm * 256 + wr * 64, lane);
    f32x4 acc[2][2][4][2];
#pragma unroll
    for (int a = 0; a < 2; ++a)
#pragma unroll
        for (int b = 0; b < 2; ++b)
#pragma unroll
            for (int m = 0; m < 4; ++m)
#pragma unroll
                for (int n = 0; n < 2; ++n) acc[a][b][m][n] = (f32x4){0.f, 0.f, 0.f, 0.f};
    bf16x8 At[4][2], B0[2][2], B1[2][2];
    const char* cA = (const char*)g.A + (size_t)cur.pm * tstep; const char* cB = (const char*)g.Bt + (size_t)cur.pn * tstep;
    PG8_STAGE(PG8_SB(0, 0), cB, voffB); PG8_STAGE(PG8_SB(0, 1), cB + hstep, voffB); PG8_STAGE(PG8_SA(0, 0), cA, voffA); PG8_STAGE(PG8_SA(0, 1), cA + hstep, voffA);
    if (wr == 1) PG8_BAR;
    PG8_WAIT_V(2); PG8_BAR;
    PG8_STAGE(PG8_SB(1, 0), cB + kstep, voffB); PG8_STAGE(PG8_SA(1, 0), cA + kstep, voffA); PG8_STAGE(PG8_SB(1, 1), cB + hstep + kstep, voffB);
    PG8_WAIT_V(6); PG8_BAR;
    for (;;) {
        const bool has_next = S.next(ui + 1, nxt);
        const char* nA = has_next ? (const char*)g.A + (size_t)nxt.pm * tstep : cA; const char* nB = has_next ? (const char*)g.Bt + (size_t)nxt.pn * tstep : cB;
        for (int t = 0; t < nt; t += 2) {
            const bool last = (t == nt - 2);
            const char* a1 = cA + (size_t)(t + 1) * kstep;
            const char* a2 = last ? nA : cA + (size_t)(t + 2) * kstep; const char* b2 = last ? nB : cB + (size_t)(t + 2) * kstep;
            const char* a3 = a2 + kstep; const char* b3 = b2 + kstep;
            PG8_LDB(B0, 0, 0); PG8_LDB(B1, 0, 1); PG8_SCHED; PG8_LDA(At, 0, 0); PG8_STAGE(PG8_SA(1, 1), a1 + hstep, voffA);
            PG8_WAIT_V(8); PG8_WAIT_L(0); PG8_BAR; PG8_MMA(0, 0, At, B0); PG8_MMA(0, 1, At, B1); PG8_BAR; PG8_SCHED;
            PG8_LDA(At, 0, 1); PG8_STAGE(PG8_SB(0, 0), b2, voffB); PG8_STAGE(PG8_SB(0, 1), b2 + hstep, voffB); PG8_STAGE(PG8_SA(0, 0), a2, voffA);
            PG8_WAIT_V(8); PG8_WAIT_L(0); PG8_BAR; PG8_MMA(1, 0, At, B0); PG8_MMA(1, 1, At, B1); PG8_BAR; PG8_SCHED;
            PG8_LDB(B0, 1, 0); PG8_LDB(B1, 1, 1); PG8_SCHED; PG8_LDA(At, 1, 0); PG8_STAGE(PG8_SA(0, 1), a2 + hstep, voffA);
            PG8_WAIT_V(8); PG8_WAIT_L(0); PG8_BAR; PG8_MMA(0, 0, At, B0); PG8_MMA(0, 1, At, B1); PG8_BAR; PG8_SCHED;
            PG8_LDA(At, 1, 1); PG8_STAGE(PG8_SB(1, 0), b3, voffB); PG8_STAGE(PG8_SB(1, 1), b3 + hstep, voffB); PG8_STAGE(PG8_SA(1, 0), a3, voffA);
            PG8_WAIT_V(8); PG8_WAIT_L(0); PG8_BAR; PG8_MMA(1, 0, At, B0); PG8_MMA(1, 1, At, B1); PG8_BAR; PG8_SCHED;
        }
        if (wr == 0) PG8_BAR;
        { const int l2 = lane_id_v(); E(acc, cur, wr, wc, l2 & 15, l2 >> 4, stn, ui); if (has_next) stn.load(E.stats, nxt.pm * 256 + wr * 64, l2); }
        if (!has_next) break;
#pragma unroll
        for (int a = 0; a < 2; ++a)
#pragma unroll
            for (int b = 0; b < 2; ++b)
#pragma unroll
                for (int m = 0; m < 4; ++m)
#pragma unroll
                    for (int n = 0; n < 2; ++n) acc[a][b][m][n] = (f32x4){0.f, 0.f, 0.f, 0.f};
        cur = nxt; cA = nA; cB = nB; ++ui;
        if (wr == 1) PG8_BAR;
    }
    PG8_WAIT_V(0);
    PG8_BAR;
#undef PG8_SA
#undef PG8_SB
#undef PG8_STAGE
#undef PG8_LDA
#undef PG8_LDB
#undef PG8_MMA
#undef PG8_WAIT_V
#undef PG8_WAIT_L
#undef PG8_BAR
#undef PG8_SCHED
}
}


struct EpiUp {
    static constexpr bool PERM = true;
    const float* stats; const cfix_t* c1; const cfix_t* c2; unsigned char* ws; const LAS float* ctab;
    __device__ __forceinline__ void operator()(const f32x4 (&acc)[2][2][4][2], const pg8::Unit& u, int wr, int wc, int fr, int fq, const UnitStats& st, int ui) const {
        asm volatile("" : "+v"(fr), "+v"(fq));
        const int lane = fr + 16 * fq, rowbase = u.pm * 256 + wr * 64;
        const int n0 = u.pn * 256 + wc * 32 + 8 * fq, gcol = u.pn * 128 + wc * 32 + 8 * fq;
        bf16_t* G = (bf16_t*)(ws + OFF_G);
        f32x4 ka1[2], ka2[2], ku1[2], ku2[2];
#pragma unroll
        for (int n = 0; n < 2; ++n) { const LAS float* ct = ctab + ui * 512 + wc * 32 + 8 * fq + 4 * n; ka1[n] = *(const LAS f32x4*)ct; ka2[n] = *(const LAS f32x4*)(ct + 256); ku1[n] = *(const LAS f32x4*)(ct + 128); ku2[n] = *(const LAS f32x4*)(ct + 384); }
#pragma unroll
        for (int ai = 0; ai < 2; ++ai)
#pragma unroll
            for (int m = 0; m < 4; ++m) {
                float mu, rs; st.get(ai, m, fr, mu, rs);
                const int r = rowbase + 128 * ai + 16 * m + fr;
                float o[8];
#pragma unroll
                for (int n = 0; n < 2; ++n) {
#pragma unroll
                    for (int j = 0; j < 4; ++j) {
                        const float av = rs * (acc[ai][0][m][n][j] - mu * ka1[n][j]) + ka2[n][j];
                        const float uu = rs * (acc[ai][1][m][n][j] - mu * ku1[n][j]) + ku2[n][j];
                        o[4 * n + j] = silu_f(av) * uu;
                    }
                }
                u32x4 w; w.x = cvt_pk_bf16(o[0], o[1]); w.y = cvt_pk_bf16(o[2], o[3]); w.z = cvt_pk_bf16(o[4], o[5]); w.w = cvt_pk_bf16(o[6], o[7]);
                __builtin_nontemporal_store(w, (u32x4*)(G + (size_t)r * GW + gcol));
            }
    }
    __device__ __forceinline__ void tail(int u, int row, int c, float p0, float p1, float q0, float q1) const {
        const int r = TM + row, n0 = (u >> 2) * 256 + (u & 3) * 32 + c, gcol = (u >> 2) * 128 + (u & 3) * 32 + c;
        float mu, rs; load_row_stat(stats, r, mu, rs);
        const float a0 = rs * (p0 - mu * cfix2f(c1[n0])) + cfix2f(c2[n0]), a1 = rs * (p1 - mu * cfix2f(c1[n0 + 1])) + cfix2f(c2[n0 + 1]);
        const float u0 = rs * (q0 - mu * cfix2f(c1[n0 + 128])) + cfix2f(c2[n0 + 128]), u1 = rs * (q1 - mu * cfix2f(c1[n0 + 129])) + cfix2f(c2[n0 + 129]);
        *(unsigned*)((bf16_t*)(ws + OFF_G) + (size_t)r * GW + gcol) = cvt_pk_bf16(silu_f(a0) * u0, silu_f(a1) * u1);
    }
};

struct EpiRes {
    static constexpr bool PERM = false;
    const float* stats; float* stats_new; const float* lg; const float* lb; float* zf; unsigned char* ws; float bscale;
    int fin; const float* fg; const float* fb; unsigned* cnt; const LAS float* ctab;
    __device__ __forceinline__ void operator()(f32x4 (&acc)[2][2][4][2], const pg8::Unit& u, int wr, int wc, int fr, int fq, const UnitStats& st, int ui) const {
        asm volatile("" : "+v"(fr), "+v"(fq));
        const int lane = fr + 16 * fq, rowbase = u.pm * 256 + wr * 64;
        const int col0 = u.pn * 256 + wc * 32 + 4 * fq;
        bf16_t* zb = (bf16_t*)(ws + OFF_ZB);
        f32x4 gvh[2][2], bvh[2][2];
#pragma unroll
        for (int bj = 0; bj < 2; ++bj)
#pragma unroll
            for (int n = 0; n < 2; ++n) { const LAS float* ct = ctab + wc * 32 + 4 * fq + 128 * bj + 16 * n; gvh[bj][n] = *(const LAS f32x4*)ct; bvh[bj][n] = *(const LAS f32x4*)(ct + 256); }
        u32x2 zp[2][2];
        { const bf16_t* z0 = zb + (size_t)(rowbase + fr) * 1024 + col0;
#pragma unroll
          for (int bj = 0; bj < 2; ++bj)
#pragma unroll
            for (int n = 0; n < 2; ++n) zp[bj][n] = *(const u32x2*)(z0 + 128 * bj + 16 * n); }
#pragma unroll
        for (int ai = 0; ai < 2; ++ai)
#pragma unroll
            for (int m = 0; m < 4; ++m) {
                float mu, rs; st.get(ai, m, fr, mu, rs);
                const int r = rowbase + 128 * ai + 16 * m + fr;
                bf16_t* br = zb + (size_t)r * 1024 + col0;
                f32x4 zc[2][2];
#pragma unroll
                for (int bj = 0; bj < 2; ++bj)
#pragma unroll
                    for (int n = 0; n < 2; ++n) { const u32x2 q = zp[bj][n]; zc[bj][n] = (f32x4){bf2f(q.x & 0xffffu), bf2f(q.x >> 16), bf2f(q.y & 0xffffu), bf2f(q.y >> 16)}; }
                if (ai * 4 + m < 7) {
                    const int rn = rowbase + 128 * ((ai * 4 + m + 1) >> 2) + 16 * ((ai * 4 + m + 1) & 3) + fr;
                    const bf16_t* zn_ = zb + (size_t)rn * 1024 + col0;
#pragma unroll
                    for (int bj = 0; bj < 2; ++bj)
#pragma unroll
                        for (int n = 0; n < 2; ++n) zp[bj][n] = *(const u32x2*)(zn_ + 128 * bj + 16 * n);
                }
                float s = 0.f, ss = 0.f;
#pragma unroll
                for (int bj = 0; bj < 2; ++bj)
#pragma unroll
                    for (int n = 0; n < 2; ++n) {
                        f32x4 zn;
                        const f32x4 gv = gvh[bj][n], bv = bvh[bj][n];
#pragma unroll
                        for (int j = 0; j < 4; ++j) { const float h = (zc[bj][n][j] - mu) * rs * gv[j] + bv[j]; zn[j] = ALPHA * h + bscale * acc[ai][bj][m][n][j]; s += zn[j]; ss += zn[j] * zn[j]; }
                        acc[ai][bj][m][n] = zn;
                        if (!fin) {
                            u32x2 w; w.x = cvt_pk_bf16(zn[0], zn[1]); w.y = cvt_pk_bf16(zn[2], zn[3]);
                            *(u32x2*)(br + 128 * bj + 16 * n) = w;
                        }
                    }
                s += shfl_x(s, lane, 16); s += shfl_x(s, lane, 32); ss += shfl_x(ss, lane, 16); ss += shfl_x(ss, lane, 32);
                if (fq == 0) *(f32x2*)(stats_new + (size_t)r * 32 + (u.pn * 4 + wc) * 2) = (f32x2){s, ss};
            }
        if (fin) {
            asm volatile("s_waitcnt vmcnt(0)" ::: "memory");
            __builtin_amdgcn_s_barrier();
            if (wr == 0 && wc == 0 && lane == 0) {
                __builtin_amdgcn_fence(__ATOMIC_RELEASE, "agent");
                asm volatile("s_waitcnt vmcnt(0)" ::: "memory");
                __hip_atomic_fetch_add(cnt + 4 * u.pm, 1u, __ATOMIC_RELAXED, __HIP_MEMORY_SCOPE_AGENT);
                unsigned sp = 0;
                while (__hip_atomic_load(cnt + 4 * u.pm, __ATOMIC_RELAXED, __HIP_MEMORY_SCOPE_AGENT) < 4u) { __builtin_amdgcn_s_sleep(1); if (++sp > (1u << 22)) break; }
                __builtin_amdgcn_fence(__ATOMIC_ACQUIRE, "agent");
                asm volatile("s_waitcnt vmcnt(0)" ::: "memory");
            }
            __builtin_amdgcn_s_barrier();
            asm volatile("" : "+v"(fr), "+v"(fq) :: "memory");
            const int lane2 = fr + 16 * fq, colf = u.pn * 256 + wc * 32 + 4 * fq;
            UnitStats sf; sf.load(stats_new, rowbase, lane2);
            f32x4 fgv[2][2], fbv[2][2];
#pragma unroll
            for (int bj = 0; bj < 2; ++bj)
#pragma unroll
                for (int n = 0; n < 2; ++n) { const LAS float* ct = ctab + 512 + wc * 32 + 4 * fq + 128 * bj + 16 * n; fgv[bj][n] = *(const LAS f32x4*)ct; fbv[bj][n] = *(const LAS f32x4*)(ct + 256); }
#pragma unroll
            for (int ai = 0; ai < 2; ++ai)
#pragma unroll
                for (int m = 0; m < 4; ++m) {
                    float mu, rs; sf.get(ai, m, fr, mu, rs);
                    const int r = rowbase + 128 * ai + 16 * m + fr;
                    float* orow = zf + (size_t)r * 1024 + colf;
#pragma unroll
                    for (int bj = 0; bj < 2; ++bj)
#pragma unroll
                        for (int n = 0; n < 2; ++n) {
                            const f32x4 gv = fgv[bj][n], bv = fbv[bj][n];
                            f32x4 o;
#pragma unroll
                            for (int j = 0; j < 4; ++j) o[j] = (acc[ai][bj][m][n][j] - mu) * rs * gv[j] + bv[j];
                            *(f32x4*)(orow + 128 * bj + 16 * n) = o;
                        }
                    asm volatile("" ::: "memory");
                }
        }
    }
    __device__ __forceinline__ void tail(int u, int row, int c, float p0, float p1, float q0, float q1) const {
        const int r = TM + row, n0 = (u >> 2) * 256 + (u & 3) * 32 + c;
        float mu, rs; load_row_stat(stats, r, mu, rs);
        bf16_t* br = (bf16_t*)(ws + OFF_ZB) + (size_t)r * 1024;
        const float acc4[4] = {p0, p1, q0, q1}; const int cols[4] = {n0, n0 + 1, n0 + 128, n0 + 129};
        float zn[4]; float s = 0.f, ss = 0.f;
#pragma unroll
        for (int k = 0; k < 4; ++k) { const float h = (bf2f(br[cols[k]]) - mu) * rs * lg[cols[k]] + lb[cols[k]]; zn[k] = ALPHA * h + bscale * acc4[k]; s += zn[k]; ss += zn[k] * zn[k]; }
        *(unsigned*)(br + n0) = cvt_pk_bf16(zn[0], zn[1]); *(unsigned*)(br + n0 + 128) = cvt_pk_bf16(zn[2], zn[3]);
        { const int ln = lane_id_v();
#pragma unroll
        for (int o = 1; o < 16; o <<= 1) { s += shfl_x(s, ln, o); ss += shfl_x(ss, ln, o); } }
        if ((c & 30) == 0) *(f32x2*)(stats_new + (size_t)r * 32 + u * 2) = (f32x2){s, ss};
    }
};

struct EpiIn {
    static constexpr bool PERM = true;
    const float* stats; const cfix_t* c1; const cfix_t* c2; unsigned char* ws; const LAS float* ctab;
    __device__ __forceinline__ void operator()(const f32x4 (&acc)[2][2][4][2], const pg8::Unit& u, int wr, int wc, int fr, int fq, const UnitStats& st, int ui) const {
        asm volatile("" : "+v"(fr), "+v"(fq));
        const int lane = fr + 16 * fq, rowbase = u.pm * 256 + wr * 64;
        const int n0 = u.pn * 256 + wc * 32 + 8 * fq, pn = u.pn;
        f32x4 k1[2][2], k2[2][2];
#pragma unroll
        for (int bj = 0; bj < 2; ++bj)
#pragma unroll
            for (int n = 0; n < 2; ++n) { const LAS float* ct = ctab + ui * 512 + 128 * bj + wc * 32 + 8 * fq + 4 * n; k1[bj][n] = *(const LAS f32x4*)ct; k2[bj][n] = *(const LAS f32x4*)(ct + 256); }
#define VAL(ai, bj, m, n, j) (rs * (acc[ai][bj][m][n][j] - mu * k1[bj][n][j]) + k2[bj][n][j])
        if (pn == 0 || pn >= 7) {
            bf16_t* dst; int ld, col; const bool act = pn >= 9;
            if (pn == 0) { dst = (bf16_t*)(ws + OFF_XP); ld = 256; col = wc * 32 + 8 * fq; } else if (pn <= 8) { dst = (bf16_t*)(ws + OFF_V); ld = 512; col = 256 * (pn - 7) + wc * 32 + 8 * fq; } else { dst = (bf16_t*)(ws + OFF_SG); ld = 512; col = 256 * (pn - 9) + wc * 32 + 8 * fq; }
#pragma unroll
            for (int ai = 0; ai < 2; ++ai)
#pragma unroll
                for (int m = 0; m < 4; ++m) {
                    float mu, rs; st.get(ai, m, fr, mu, rs);
                    const int r = rowbase + 128 * ai + 16 * m + fr;
#pragma unroll
                    for (int bj = 0; bj < 2; ++bj) {
                        float o[8];
#pragma unroll
                        for (int n = 0; n < 2; ++n)
#pragma unroll
                            for (int j = 0; j < 4; ++j) { const float v = VAL(ai, bj, m, n, j); o[4 * n + j] = act ? silu_f(v) : v; }
                        u32x4 w; w.x = cvt_pk_bf16(o[0], o[1]); w.y = cvt_pk_bf16(o[2], o[3]); w.z = cvt_pk_bf16(o[4], o[5]); w.w = cvt_pk_bf16(o[6], o[7]);
                        *(u32x4*)(dst + (size_t)r * ld + col + 128 * bj) = w;
                    }
                }
        } else if (pn <= 2) {
            const int col = 128 * (pn - 1) + wc * 32 + 8 * fq;
            bf16_t* U = (bf16_t*)(ws + OFF_U);
#pragma unroll
            for (int ai = 0; ai < 2; ++ai)
#pragma unroll
                for (int m = 0; m < 4; ++m) {
                    float mu, rs; st.get(ai, m, fr, mu, rs);
                    const int r = rowbase + 128 * ai + 16 * m + fr;
                    float o[8];
#pragma unroll
                    for (int n = 0; n < 2; ++n)
#pragma unroll
                        for (int j = 0; j < 4; ++j) o[4 * n + j] = VAL(ai, 0, m, n, j) * fast_sigmoid(VAL(ai, 1, m, n, j));
                    u32x4 w; w.x = cvt_pk_bf16(o[0], o[1]); w.y = cvt_pk_bf16(o[2], o[3]); w.z = cvt_pk_bf16(o[4], o[5]); w.w = cvt_pk_bf16(o[6], o[7]);
                    *(u32x4*)(U + (size_t)r * 256 + col) = w;
                }
        } else {
            const bool isk = pn >= 5;
            const int head = 2 * ((pn - 3) & 1) + (wc >> 1), d0 = 32 * (wc & 1) + 8 * fq;
            bf16_t* dst = (bf16_t*)(ws + (isk ? OFF_K : OFF_Q)); bf16_t* K2 = (bf16_t*)(ws + OFF_K2);
            const float* rope = (const float*)(ws + OFF_ROPE);
            const float scale = isk ? 0.08838834764831845f : 1.0f;
            const float lgam = log2_gamma(head);
            f32x4 csn[4];
            { const f32x4* cs0 = (const f32x4*)(rope + ((size_t)(((rowbase + fr) & 8191) + NMETA) * 64 + d0) * 2);
#pragma unroll
              for (int q = 0; q < 4; ++q) csn[q] = cs0[q]; }
#pragma unroll
            for (int ai = 0; ai < 2; ++ai)
#pragma unroll
                for (int m = 0; m < 4; ++m) {
                    float mu, rs; st.get(ai, m, fr, mu, rs);
                    const int r = rowbase + 128 * ai + 16 * m + fr;
                    const int ci = r & 63;
                    f32x4 cs[4];
#pragma unroll
                    for (int q = 0; q < 4; ++q) cs[q] = csn[q];
                    if (ai * 4 + m < 7) {
                        const int rn = rowbase + 128 * ((ai * 4 + m + 1) >> 2) + 16 * ((ai * 4 + m + 1) & 3) + fr;
                        const f32x4* csp = (const f32x4*)(rope + ((size_t)((rn & 8191) + NMETA) * 64 + d0) * 2);
#pragma unroll
                        for (int q = 0; q < 4; ++q) csn[q] = csp[q];
                    }
                    const size_t off = (size_t)r * 512 + head * 128 + d0;
                    float o1[8], o2[8];
#pragma unroll
                    for (int n = 0; n < 2; ++n) {
                        const f32x4 csA = cs[2 * n], csB = cs[2 * n + 1];
                        const float cc[4] = {csA.x, csA.z, csB.x, csB.z}, sn[4] = {csA.y, csA.w, csB.y, csB.w};
#pragma unroll
                        for (int j = 0; j < 4; ++j) { const float x1 = VAL(ai, 0, m, n, j), x2 = VAL(ai, 1, m, n, j);
                            o1[4 * n + j] = (x1 * cc[j] - x2 * sn[j]) * scale; o2[4 * n + j] = (x2 * cc[j] + x1 * sn[j]) * scale; }
                    }
                    {
                        u32x4 w1, w2; w1.x = cvt_pk_bf16(o1[0], o1[1]); w1.y = cvt_pk_bf16(o1[2], o1[3]); w1.z = cvt_pk_bf16(o1[4], o1[5]); w1.w = cvt_pk_bf16(o1[6], o1[7]);
                        w2.x = cvt_pk_bf16(o2[0], o2[1]); w2.y = cvt_pk_bf16(o2[2], o2[3]); w2.z = cvt_pk_bf16(o2[4], o2[5]); w2.w = cvt_pk_bf16(o2[6], o2[7]);
                        *(u32x4*)(dst + off) = w1; *(u32x4*)(dst + off + 64) = w2;
                    }
                }
        }
#undef VAL
    }
    __device__ __forceinline__ void tail(int u, int row, int c, float p0, float p1, float q0, float q1) const {
        bf16_t *XP = (bf16_t*)(ws + OFF_XP), *U = (bf16_t*)(ws + OFF_U), *Q = (bf16_t*)(ws + OFF_Q), *K = (bf16_t*)(ws + OFF_K), *K2 = (bf16_t*)(ws + OFF_K2), *V = (bf16_t*)(ws + OFF_V), *SG = (bf16_t*)(ws + OFF_SG);
        const float* rope = (const float*)(ws + OFF_ROPE);
        const int r = TM + row, pn = u >> 2, wc = u & 3, n0 = pn * 256 + wc * 32 + c;
        float mu, rs; load_row_stat(stats, r, mu, rs);
        const float a0 = rs * (p0 - mu * cfix2f(c1[n0])) + cfix2f(c2[n0]), a1 = rs * (p1 - mu * cfix2f(c1[n0 + 1])) + cfix2f(c2[n0 + 1]);
        const float b0 = rs * (q0 - mu * cfix2f(c1[n0 + 128])) + cfix2f(c2[n0 + 128]), b1 = rs * (q1 - mu * cfix2f(c1[n0 + 129])) + cfix2f(c2[n0 + 129]);
        if (pn == 0 || pn >= 7) {
            bf16_t* dst; int ld, col; const bool act = pn >= 9;
            if (pn == 0) { dst = XP; ld = 256; col = wc * 32 + c; } else if (pn <= 8) { dst = V; ld = 512; col = 256 * (pn - 7) + wc * 32 + c; } else { dst = SG; ld = 512; col = 256 * (pn - 9) + wc * 32 + c; }
            *(unsigned*)(dst + (size_t)r * ld + col) = act ? cvt_pk_bf16(silu_f(a0), silu_f(a1)) : cvt_pk_bf16(a0, a1);
            *(unsigned*)(dst + (size_t)r * ld + col + 128) = act ? cvt_pk_bf16(silu_f(b0), silu_f(b1)) : cvt_pk_bf16(b0, b1);
        } else if (pn <= 2) {
            *(unsigned*)(U + (size_t)r * 256 + 128 * (pn - 1) + wc * 32 + c) = cvt_pk_bf16(a0 * fast_sigmoid(b0), a1 * fast_sigmoid(b1));
        } else {
            const bool isk = pn >= 5;
            const int head = 2 * ((pn - 3) & 1) + (wc >> 1), d = 32 * (wc & 1) + c, t = row & 15, ci = 48 + t;
            const float scale = isk ? 0.08838834764831845f : 1.0f;
            const f32x4 cs = *(const f32x4*)(rope + ((size_t)t * 64 + d) * 2);
            const float o10 = (a0 * cs.x - b0 * cs.y) * scale, o20 = (b0 * cs.x + a0 * cs.y) * scale;
            const float o11 = (a1 * cs.z - b1 * cs.w) * scale, o21 = (b1 * cs.z + a1 * cs.w) * scale;
            bf16_t* dst = isk ? K : Q; const size_t off = (size_t)r * 512 + head * 128 + d;
            *(unsigned*)(dst + off) = cvt_pk_bf16(o10, o11); *(unsigned*)(dst + off + 64) = cvt_pk_bf16(o20, o21);
        }
    }
};

template <class Epi>
__device__ __forceinline__ void tail_units(unsigned char* smem, const bf16_t* At, const bf16_t* Bt, int K, int nunits, int c0, const Epi& E, const int tid, const int bid) {
    const int wid = tid >> 6, lane = tid & 63; constexpr int G = GRID;
    float* part = (float*)smem;
    const int kw = K / 8;
    for (int u = (bid - c0 + G) % G; u < nunits; u += G) {
        const int n0 = (u >> 2) * 256 + (u & 3) * 32;
        f32x16 acc0, acc1;
#pragma unroll
        for (int i = 0; i < 16; ++i) { acc0[i] = 0.f; acc1[i] = 0.f; }
        const bf16_t* ap = At + (size_t)(lane & 31) * K + wid * kw + 8 * (lane >> 5);
        const bf16_t* bp0 = Bt + (size_t)(n0 + (lane & 31)) * K + wid * kw + 8 * (lane >> 5);
        const bf16_t* bp1 = bp0 + (size_t)128 * K;
        for (int k0 = 0; k0 < kw; k0 += 64) {
            bf16x8 av[4], b0v[4], b1v[4];
#pragma unroll
            for (int j = 0; j < 4; ++j) if (k0 + 16 * j < kw) { av[j] = *(const bf16x8*)(ap + k0 + 16 * j); b0v[j] = *(const bf16x8*)(bp0 + k0 + 16 * j); b1v[j] = *(const bf16x8*)(bp1 + k0 + 16 * j); }
#pragma unroll
            for (int j = 0; j < 4; ++j) if (k0 + 16 * j < kw) {
                acc0 = __builtin_amdgcn_mfma_f32_32x32x16_bf16(av[j], b0v[j], acc0, 0, 0, 0);
                acc1 = __builtin_amdgcn_mfma_f32_32x32x16_bf16(av[j], b1v[j], acc1, 0, 0, 0);
            }
        }
#pragma unroll
        for (int i = 0; i < 16; ++i) { const int row = (i & 3) + 8 * (i >> 2) + 4 * (lane >> 5); part[wid * 2048 + row * 64 + (lane & 31)] = acc0[i]; part[wid * 2048 + row * 64 + 32 + (lane & 31)] = acc1[i]; }
        __syncthreads();
        const int row = tid >> 4, c = (tid & 15) * 2;
        float p0 = 0.f, p1 = 0.f, q0 = 0.f, q1 = 0.f;
#pragma unroll
        for (int w = 0; w < 8; ++w) { const float* pp = part + w * 2048 + row * 64 + c; p0 += pp[0]; p1 += pp[1]; q0 += pp[32]; q1 += pp[33]; }
        E.tail(u, row, c, p0, p1, q0, q1);
        __syncthreads();
    }
}


__device__ __forceinline__ bf16x8 tr_frag(const unsigned char* tile, int stride, int row0, int col0, int lane) {
    const int g = lane >> 4, q = (lane & 15) >> 2, p = lane & 3;
    const unsigned char* a0 = tile + (row0 + 4 * g + q) * stride + (col0 + 4 * p) * 2;
    const v4i16_t lo = __builtin_amdgcn_ds_read_tr16_b64_v4i16((LAS v4i16_t*)(a0));
    const v4i16_t hi = __builtin_amdgcn_ds_read_tr16_b64_v4i16((LAS v4i16_t*)(a0 + 16 * stride));
    bf16x8 r; r[0] = lo[0]; r[1] = lo[1]; r[2] = lo[2]; r[3] = lo[3]; r[4] = hi[0]; r[5] = hi[1]; r[6] = hi[2]; r[7] = hi[3];
    return r;
}
template <int NKS>
__device__ __forceinline__ void tile_gemm_loadB(bf16x8 (&bf)[NKS][2], const bf16_t* Bt, int ks_lo, int wave, int lane) {
    const bf16_t* bp = Bt + (size_t)(32 * wave + (lane & 15)) * 256 + 8 * (lane >> 4) + 32 * ks_lo;
#pragma unroll
    for (int ks = 0; ks < NKS; ++ks) { bf[ks][0] = *(const bf16x8*)(bp + 32 * ks); bf[ks][1] = *(const bf16x8*)(bp + 16 * 256 + 32 * ks); }
}
template <int NKS>
__device__ __forceinline__ void tile_gemm64(const unsigned char* At, int ast, const bf16x8 (&bf)[NKS][2], int ks_lo, int lane, f32x4 (&acc)[4][2]) {
#pragma unroll
    for (int mt = 0; mt < 4; ++mt) { acc[mt][0] = (f32x4){0.f, 0.f, 0.f, 0.f}; acc[mt][1] = (f32x4){0.f, 0.f, 0.f, 0.f}; }
    const unsigned char* ap = At + (lane & 15) * ast + 16 * (lane >> 4) + 64 * ks_lo;
#pragma unroll
    for (int ks = 0; ks < NKS; ++ks) {
#pragma unroll
        for (int mt = 0; mt < 4; ++mt) {
            const bf16x8 av = *(const bf16x8*)(ap + 16 * mt * ast + 64 * ks);
            acc[mt][0] = __builtin_amdgcn_mfma_f32_16x16x32_bf16(bf[ks][0], av, acc[mt][0], 0, 0, 0);
            acc[mt][1] = __builtin_amdgcn_mfma_f32_16x16x32_bf16(bf[ks][1], av, acc[mt][1], 0, 0, 0);
        }
    }
}
__device__ __forceinline__ void load_tok_tile(unsigned char* tile, const bf16_t* src, int b, int t0, int halo, int tid) {
    const int nchunk = (64 + halo) * 32;
    u32x4 v[6];
#pragma unroll
    for (int k = 0; k < 6; ++k) {
        const int idx = tid + 512 * k, row = idx >> 5, ch = idx & 31, t = t0 - halo + row;
        const bool ok = idx < nchunk && t >= 0 && t < LSEQ;
        const u32x4 ld = *(const u32x4*)(src + (size_t)tok_row(b, ok ? t : 0) * 256 + ch * 8);
        v[k] = ok ? ld : (u32x4){0u, 0u, 0u, 0u};
    }
#pragma unroll
    for (int k = 0; k < 6; ++k) { const int idx = tid + 512 * k, row = idx >> 5, ch = idx & 31; if (idx < nchunk) *(u32x4*)(tile + row * 512 + ch * 16) = v[k]; }
}
constexpr int ATS = 528;
constexpr int YS = 260;
constexpr int KTS = 272;
constexpr int LDS_AT = 49152, LDS_Y = 49152;

__device__ __forceinline__ void store_tile64(const f32x4 (&acc)[4][2], bf16_t* YC, int colbase, int b, int t0, int wave, int lane) {
#pragma unroll
    for (int mt = 0; mt < 4; ++mt) {
        const int t = t0 + 16 * mt + (lane & 15);
        if (t < LSEQ) {
            bf16_t* dst = YC + (size_t)tok_row(b, t) * 1024 + colbase + 32 * wave + 4 * (lane >> 4);
#pragma unroll
            for (int nt = 0; nt < 2; ++nt) { u32x2 w; w.x = cvt_pk_bf16(acc[mt][nt][0], acc[mt][nt][1]); w.y = cvt_pk_bf16(acc[mt][nt][2], acc[mt][nt][3]); *(u32x2*)(dst + 16 * nt) = w; }
        }
    }
}

__device__ __forceinline__ void pool_item(unsigned char* smem, const bf16_t* XP, const bf16_t* PPT, bf16_t* YC, int b, int tb, int tid) {
    const int t0 = 64 * tb, lane = tid & 63, wave = tid >> 6;
    load_tok_tile(smem, XP, b, t0, 15, tid);
    bf16x8 bfr[2][2]; tile_gemm_loadB<2>(bfr, PPT, 2 * (wave >> 1), wave, lane);
    __syncthreads();
    {
        const int c = tid & 255, i0 = (tid >> 8) * 32, gi = c >> 6, w = 2 << gi;
        const bf16_t* xt = (const bf16_t*)smem;
        float s = 0.f;
#pragma unroll 1
        for (int k = 1; k < w; ++k) s += bf2f(xt[(i0 + 15 - k) * 256 + c]);
        bf16_t* at = (bf16_t*)(smem + LDS_AT);
#pragma unroll 1
        for (int ib = i0; ib < i0 + 32; ib += 8) {
            unsigned short xa[8], xo[8];
#pragma unroll
            for (int q = 0; q < 8; ++q) { xa[q] = xt[(ib + q + 15) * 256 + c]; xo[q] = xt[(ib + q + 15 - (w - 1)) * 256 + c]; }
#pragma unroll
            for (int q = 0; q < 8; ++q) {
                const float xv = bf2f(xa[q]);
                s += xv;
                const int t = t0 + ib + q, cnt = (t + 1 < w) ? (t + 1) : w;
                at[(ib + q) * (ATS / 2) + c] = (bf16_t)f2bf(s * __builtin_amdgcn_rcpf((float)cnt) - xv);
                s -= bf2f(xo[q]);
            }
        }
    }
    __syncthreads();
    f32x4 acc[4][2];
    tile_gemm64<2>(smem + LDS_AT, ATS, bfr, 2 * (wave >> 1), lane, acc);
    store_tile64(acc, YC, 0, b, t0, wave, lane);
    __syncthreads();
}

__device__ __forceinline__ void conv_item(unsigned char* smem, const bf16_t* U, const bf16_t* PWT, const float* dw, const float* db, const float* lng, const float* lnb, bf16_t* YC, int b, int tb, int tid) {
    const int t0 = 64 * tb, lane = tid & 63, wave = tid >> 6;
    float w[31];
    {
        const int c = tid & 255;
#pragma unroll
        for (int j = 0; j < 31; ++j) w[j] = dw[j * 256 + c];
    }
    const float bias = db[tid & 255];
    load_tok_tile(smem, U, b, t0, 30, tid);
    __syncthreads();
    {
        const int c = tid & 255, i0 = (tid >> 8) * 32;
        const bf16_t* ut = (const bf16_t*)smem;
        float* Y = (float*)(smem + LDS_Y);
#pragma unroll 1
        for (int grp = 0; grp < 4; ++grp) {
            float a8[8];
#pragma unroll
            for (int i = 0; i < 8; ++i) a8[i] = bias;
            const bf16_t* up = ut + (i0 + grp * 8) * 256 + c;
#pragma unroll
            for (int jb = 0; jb < 40; jb += 8) {
                unsigned short raw[8];
#pragma unroll
                for (int q = 0; q < 8; ++q) raw[q] = (jb + q < 38) ? up[(jb + q) * 256] : (unsigned short)0;
#pragma unroll
                for (int q = 0; q < 8; ++q) {
                    const int jj = jb + q; const float v = bf2f(raw[q]);
#pragma unroll
                    for (int i = 0; i < 8; ++i) if (jj < 38 && jj - i >= 0 && jj - i <= 30) a8[i] += w[jj - i] * v;
                }
            }
#pragma unroll
            for (int i = 0; i < 8; ++i) Y[(i0 + grp * 8 + i) * YS + c] = a8[i];
        }
    }
    __syncthreads();
    bf16x8 bfr[8][2]; tile_gemm_loadB<8>(bfr, PWT, 0, wave, lane);
    {
        const float* Y = (const float*)(smem + LDS_Y);
        const f32x4 gg = *(const f32x4*)(lng + 4 * lane), bb = *(const f32x4*)(lnb + 4 * lane);
#pragma unroll 2
        for (int k = 0; k < 8; ++k) {
            const int tok = 8 * wave + k;
            f32x4 y = *(const f32x4*)(Y + tok * YS + 4 * lane);
            float s1 = (y.x + y.y) + (y.z + y.w), s2 = (y.x * y.x + y.y * y.y) + (y.z * y.z + y.w * y.w);
#pragma unroll
            for (int o = 1; o < 64; o <<= 1) { s1 += shfl_x(s1, lane, o); s2 += shfl_x(s2, lane, o); }
            const float mean = s1 * (1.f / 256.f);
            const float rstd = rsqrtf(fmaxf(s2 * (1.f / 256.f) - mean * mean, 0.f) + LN_EPS);
            y = y - mean;
            const f32x4 n = y * rstd * gg + bb;
            u32x2 pk; pk.x = cvt_pk_bf16(silu_f(n.x), silu_f(n.y)); pk.y = cvt_pk_bf16(silu_f(n.z), silu_f(n.w));
            *(u32x2*)(smem + tok * ATS + 8 * lane) = pk;
        }
    }
    __syncthreads();
    f32x4 acc[4][2];
    tile_gemm64<8>(smem, ATS, bfr, 0, lane, acc);
    store_tile64(acc, YC, 256, b, t0, wave, lane);
    __syncthreads();
}

__device__ __forceinline__ int chunk_row(int b, int n, int p) { return n == 0 ? (p >= 48 ? TM + 16 * b + p - 48 : -1) : SEQ * b + 64 * (n - 1) + p; }
__device__ __forceinline__ void chunk_tile_load(u32x4 (&v)[2], const bf16_t* src, int b, int n, int h, int tid) {
#pragma unroll
    for (int k = 0; k < 2; ++k) {
        const int idx = tid + 512 * k, p = idx >> 4, ch = idx & 15, row = chunk_row(b, n, p);
        const u32x4 ld = *(const u32x4*)(src + (size_t)(row >= 0 ? row : 0) * 512 + h * 128 + ch * 8);
        v[k] = row >= 0 ? ld : (u32x4){0u, 0u, 0u, 0u};
    }
}
__device__ __forceinline__ void chunk_tile_store(unsigned char* tile, const u32x4 (&v)[2], int tid) {
#pragma unroll
    for (int k = 0; k < 2; ++k) { const int idx = tid + 512 * k, p = idx >> 4, ch = idx & 15; *(u32x4*)(tile + p * KTS + ch * 16) = v[k]; }
}
template <int NP>
__device__ __forceinline__ void kv_item(unsigned char* smem, const bf16_t* K2, const bf16_t* V, bf16_t* ST, int bh, int n, int tid) {
    const int lane = tid & 63, wave = tid >> 6, b = bh >> 2, h = bh & 3;
    {
        u32x4 vk[NP][2], vv[NP][2];
#pragma unroll
        for (int c = 0; c < NP; ++c) { chunk_tile_load(vk[c], K2, b, n + c, h, tid); chunk_tile_load(vv[c], V, b, n + c, h, tid); }
        {
            const float lgam = log2_gamma(h);
#pragma unroll
            for (int c = 0; c < NP; ++c)
#pragma unroll
                for (int k2 = 0; k2 < 2; ++k2) {
                    const float dec = __builtin_amdgcn_exp2f(lgam * (float)(63 - ((tid + 512 * k2) >> 4)));
                    u32x4 q = vk[c][k2];
                    q.x = cvt_pk_bf16(bf2f(q.x & 0xffffu) * dec, bf2f(q.x >> 16) * dec); q.y = cvt_pk_bf16(bf2f(q.y & 0xffffu) * dec, bf2f(q.y >> 16) * dec);
                    q.z = cvt_pk_bf16(bf2f(q.z & 0xffffu) * dec, bf2f(q.z >> 16) * dec); q.w = cvt_pk_bf16(bf2f(q.w & 0xffffu) * dec, bf2f(q.w >> 16) * dec);
                    vk[c][k2] = q;
                }
        }
#pragma unroll
        for (int c = 0; c < NP; ++c) { chunk_tile_store(smem + c * 128 * KTS, vk[c], tid); chunk_tile_store(smem + c * 128 * KTS + 64 * KTS, vv[c], tid); }
    }
    __syncthreads();
    const int dt0 = 2 * (wave & 3), et0 = 4 * (wave >> 2);
#pragma unroll
    for (int c = 0; c < NP; ++c) {
        const unsigned char* kt = smem + c * 128 * KTS;
        f32x4 acc[2][4];
#pragma unroll
        for (int dt = 0; dt < 2; ++dt)
#pragma unroll
            for (int et = 0; et < 4; ++et) acc[dt][et] = (f32x4){0.f, 0.f, 0.f, 0.f};
#pragma unroll
        for (int ks = 0; ks < 2; ++ks) {
            bf16x8 af[2], bfr[4];
#pragma unroll
            for (int dt = 0; dt < 2; ++dt) af[dt] = tr_frag(kt, KTS, 32 * ks, 16 * (dt0 + dt), lane);
#pragma unroll
            for (int et = 0; et < 4; ++et) bfr[et] = tr_frag(kt + 64 * KTS, KTS, 32 * ks, 16 * (et0 + et), lane);
#pragma unroll
            for (int dt = 0; dt < 2; ++dt)
#pragma unroll
                for (int et = 0; et < 4; ++et) acc[dt][et] = __builtin_amdgcn_mfma_f32_16x16x32_bf16(af[dt], bfr[et], acc[dt][et], 0, 0, 0);
        }
        bf16_t* dst = ST + ((size_t)(bh * NCHUNK + n + c)) * 16384;
#pragma unroll
        for (int dt = 0; dt < 2; ++dt)
#pragma unroll
            for (int et = 0; et < 4; ++et) { u32x2 w; w.x = cvt_pk_bf16(acc[dt][et][0], acc[dt][et][1]); w.y = cvt_pk_bf16(acc[dt][et][2], acc[dt][et][3]);
                *(u32x2*)(dst + (16 * (et0 + et) + (lane & 15)) * 128 + 16 * (dt0 + dt) + 4 * (lane >> 4)) = w; }
    }
    __syncthreads();
}

struct RetRegs { u32x4 vk[2], vv[2], vs[4]; bf16x8 qf[4]; u32x4 sg[2]; };
__device__ __forceinline__ void ret_load(RetRegs& R, const bf16_t* Q, const bf16_t* Kb, const bf16_t* V, const bf16_t* ST, const bf16_t* SG, int bh, int n, int tid) {
    const int lane = tid & 63, wave = tid >> 6, b = bh >> 2, h = bh & 3, g = lane >> 4, li = lane & 15, it = wave & 3, eh = wave >> 2;
    chunk_tile_load(R.vk, Kb, b, n, h, tid); chunk_tile_load(R.vv, V, b, n, h, tid);
    const bf16_t* sp = ST + ((size_t)(bh * NCHUNK + n)) * 16384;
#pragma unroll
    for (int k = 0; k < 4; ++k) { const int idx = tid + 512 * k, e = idx >> 4, ch = idx & 15; R.vs[k] = *(const u32x4*)(sp + e * 128 + ch * 8); }
    const int qrow = chunk_row(b, n, 16 * it + li);
#pragma unroll
    for (int ks = 0; ks < 4; ++ks) { const bf16x8 ld = *(const bf16x8*)(Q + (size_t)(qrow >= 0 ? qrow : 0) * 512 + h * 128 + 32 * ks + 8 * g); R.qf[ks] = qrow >= 0 ? ld : (bf16x8){0, 0, 0, 0, 0, 0, 0, 0}; }
#pragma unroll
    for (int k = 0; k < 2; ++k) {
        const int idx = tid + 512 * k, p = idx >> 4, ch = idx & 15, row = chunk_row(b, n, p);
        const u32x4 ld = *(const u32x4*)(SG + (size_t)(row >= 0 ? row : 0) * 512 + h * 128 + ch * 8);
        R.sg[k] = row >= 0 ? ld : (u32x4){0u, 0u, 0u, 0u};
    }
}
__device__ __forceinline__ void ret_item(unsigned char* smem, RetRegs& R, const bf16_t* Q, const bf16_t* Kb, const bf16_t* V, const bf16_t* ST, const bf16_t* SG, const float* gng, bf16_t* YC, int bh, int n, bool has_next, int nbh, int nn, int tid) {
    const int lane = tid & 63, wave = tid >> 6, b = bh >> 2, h = bh & 3, g = lane >> 4, li = lane & 15;
    unsigned char* KT = smem; unsigned char* VT = smem + 64 * KTS; unsigned char* STt = smem + 128 * KTS; float* PS = (float*)(smem + 256 * KTS);
    const int it = wave & 3, eh = wave >> 2;
    chunk_tile_store(KT, R.vk, tid); chunk_tile_store(VT, R.vv, tid);
#pragma unroll
    for (int k = 0; k < 4; ++k) { const int idx = tid + 512 * k, e = idx >> 4, ch = idx & 15; *(u32x4*)(STt + e * KTS + ch * 16) = R.vs[k]; }
    bf16x8 qf[4]; u32x4 sgc[2];
#pragma unroll
    for (int ks = 0; ks < 4; ++ks) qf[ks] = R.qf[ks];
    sgc[0] = R.sg[0]; sgc[1] = R.sg[1];
    __syncthreads();
    if (has_next) ret_load(R, Q, Kb, V, ST, SG, nbh, nn, tid);
    const float lgam = log2_gamma(h);
    float ggv[4];
#pragma unroll
    for (int et = 0; et < 4; ++et) ggv[et] = gng[h * 128 + 64 * eh + 16 * et + li];
    bf16x8 pf[2];
#pragma unroll
    for (int jt = 0; jt < 4; ++jt) {
        f32x4 sacc = (f32x4){0.f, 0.f, 0.f, 0.f};
#pragma unroll
        for (int ks = 0; ks < 4; ++ks) { const bf16x8 kf = *(const bf16x8*)(KT + (16 * jt + li) * KTS + 64 * ks + 16 * g); sacc = __builtin_amdgcn_mfma_f32_16x16x32_bf16(kf, qf[ks], sacc, 0, 0, 0); }
        const int i = 16 * it + li;
#pragma unroll
        for (int r = 0; r < 4; ++r) { const int j = 16 * jt + 4 * g + r, dist = i > j ? i - j : j - i; sacc[r] *= __builtin_amdgcn_exp2f(lgam * (float)dist); }
        const unsigned lo = cvt_pk_bf16(sacc[0], sacc[1]), hi = cvt_pk_bf16(sacc[2], sacc[3]);
        const int base = 4 * (jt & 1);
        pf[jt >> 1][base + 0] = (short)(lo & 0xffffu); pf[jt >> 1][base + 1] = (short)(lo >> 16); pf[jt >> 1][base + 2] = (short)(hi & 0xffffu); pf[jt >> 1][base + 3] = (short)(hi >> 16);
    }
    f32x4 o[4];
#pragma unroll
    for (int et = 0; et < 4; ++et) {
        const int e0 = 64 * eh + 16 * et;
        f32x4 a = (f32x4){0.f, 0.f, 0.f, 0.f};
#pragma unroll
        for (int ks = 0; ks < 4; ++ks) { const bf16x8 sf = *(const bf16x8*)(STt + (e0 + li) * KTS + 64 * ks + 16 * g); a = __builtin_amdgcn_mfma_f32_16x16x32_bf16(qf[ks], sf, a, 0, 0, 0); }
#pragma unroll
        for (int r = 0; r < 4; ++r) a[r] *= __builtin_amdgcn_exp2f(lgam * (float)(16 * it + 4 * g + r + 1));
#pragma unroll
        for (int ks = 0; ks < 2; ++ks) { const bf16x8 vf = tr_frag(VT, KTS, 32 * ks, e0, lane); a = __builtin_amdgcn_mfma_f32_16x16x32_bf16(pf[ks], vf, a, 0, 0, 0); }
        o[et] = a;
    }
    float ps[4], pss[4];
#pragma unroll
    for (int r = 0; r < 4; ++r) { float s1 = 0.f, s2 = 0.f;
#pragma unroll
        for (int et = 0; et < 4; ++et) { s1 += o[et][r]; s2 += o[et][r] * o[et][r]; }
#pragma unroll
        for (int m = 1; m < 16; m <<= 1) { s1 += shfl_x(s1, lane, m); s2 += shfl_x(s2, lane, m); }
        ps[r] = s1; pss[r] = s2; }
    if (li == 0) {
#pragma unroll
        for (int r = 0; r < 4; ++r) *(f32x2*)(PS + (eh * 64 + 16 * it + 4 * g + r) * 2) = (f32x2){ps[r], pss[r]};
    }
    __syncthreads();
#pragma unroll
    for (int r = 0; r < 4; ++r) {
        const int p = 16 * it + 4 * g + r, row = chunk_row(b, n, p);
        const f32x2 oth = *(const f32x2*)(PS + ((eh ^ 1) * 64 + p) * 2);
        const float mean = (ps[r] + oth.x) * (1.f / 128.f);
        const float var = (pss[r] + oth.y) * (1.f / 128.f) - mean * mean;
        const float rstd = rsqrtf(fmaxf(var, 0.f) + LN_EPS);
        {
#pragma unroll
            for (int et = 0; et < 4; ++et) ((bf16_t*)KT)[p * (KTS / 2) + 64 * eh + 16 * et + li] = (bf16_t)f2bf((o[et][r] - mean) * rstd * ggv[et]);
        }
    }
    __syncthreads();
#pragma unroll
    for (int k = 0; k < 2; ++k) {
        const int idx = tid + 512 * k, p = idx >> 4, ch = idx & 15, row = chunk_row(b, n, p);
        const u32x4 y = *(const u32x4*)(KT + p * KTS + ch * 16), q = sgc[k];
        u32x4 w;
        w.x = cvt_pk_bf16(bf2f(y.x & 0xffffu) * bf2f(q.x & 0xffffu), bf2f(y.x >> 16) * bf2f(q.x >> 16));
        w.y = cvt_pk_bf16(bf2f(y.y & 0xffffu) * bf2f(q.y & 0xffffu), bf2f(y.y >> 16) * bf2f(q.y >> 16));
        w.z = cvt_pk_bf16(bf2f(y.z & 0xffffu) * bf2f(q.z & 0xffffu), bf2f(y.z >> 16) * bf2f(q.z >> 16));
        w.w = cvt_pk_bf16(bf2f(y.w & 0xffffu) * bf2f(q.w & 0xffffu), bf2f(y.w >> 16) * bf2f(q.w >> 16));
        if (row >= 0) *(u32x4*)(YC + (size_t)row * 1024 + 512 + h * 128 + ch * 8) = w;
    }
    __syncthreads();
}

#define XB_TMO      128
#define XB_XCNT(j)  (256  + 64 * (j))
#define XB_XSUB(j)  (1280 + 64 * (j))
#define XB_XGEN(j)  (2304 + 64 * (j))
#define XB_TOP      3328
#define XB_TOPGEN   3392
#define XCD_BAR_WORDS 3456
#define XB_SPIN_CAP (1u << 22)
__device__ __forceinline__ unsigned xb_ld(unsigned* p)              { return __hip_atomic_load(p, __ATOMIC_RELAXED, __HIP_MEMORY_SCOPE_AGENT); }
__device__ __forceinline__ unsigned xb_add(unsigned* p, unsigned v) { return __hip_atomic_fetch_add(p, v, __ATOMIC_RELAXED, __HIP_MEMORY_SCOPE_AGENT); }
__device__ __forceinline__ unsigned xb_xcc_id() { return (unsigned)__builtin_amdgcn_s_getreg((3 << 11) | 20) & 0xFu; }
#define XB_SPIN(cond, bar) do { unsigned _sp = 0; while (cond) { __builtin_amdgcn_s_sleep(1); \
    if ((++_sp & 255u) == 0u) { if (xb_ld(&(bar)[XB_TMO])) break; if (_sp > XB_SPIN_CAP) { atomicAdd(&(bar)[XB_TMO], 1u); break; } } } } while (0)
struct XcdBarrier { unsigned* bar; unsigned x; volatile LAS unsigned* st; };
__device__ __forceinline__ XcdBarrier xcd_barrier_post(unsigned* bar, volatile LAS unsigned* st) {
    XcdBarrier b; b.bar = bar; b.x = xb_xcc_id(); b.st = st;
    if (threadIdx.x == 0) (void)xb_add(&bar[XB_XCNT(b.x)], 1u);
    return b;
}
__device__ __forceinline__ void xcd_barrier_complete(unsigned* bar, unsigned x, unsigned& nloc, unsigned& nx) {
    const unsigned G = gridDim.x * gridDim.y * gridDim.z;
    unsigned sum, cnt, mine, sp = 0u;
    for (;;) {
        sum = 0u; cnt = 0u; mine = 0u;
#pragma unroll
        for (unsigned j = 0; j < 16; ++j) { const unsigned c = xb_ld(&bar[XB_XCNT(j)]); sum += c; cnt += (c > 0u) ? 1u : 0u; mine = (j == x) ? c : mine; }
        if (sum == G) break;
        __builtin_amdgcn_s_sleep(1);
        if ((++sp & 255u) == 0u) { if (xb_ld(&bar[XB_TMO])) break; if (sp > XB_SPIN_CAP) { atomicAdd(&bar[XB_TMO], 1u); break; } }
    }
    nloc = mine > 0u ? mine : 1u; nx = cnt > 0u ? cnt : 1u;
}
__device__ __forceinline__ void xcd_barrier(const XcdBarrier& b, const int wave_s) {
    asm volatile("s_waitcnt vmcnt(0)" ::: "memory");
    __syncthreads();
    if (wave_s == 0 && lane_id_v() == 0) {
        unsigned* bar = b.bar;
        asm volatile("" : "+s"(bar));
        __builtin_amdgcn_s_waitcnt(0);
        unsigned nloc = b.st[0], nx = b.st[1];
        if (nloc == 0u) { xcd_barrier_complete(bar, b.x, nloc, nx); b.st[0] = nloc; b.st[1] = nx; }
        const unsigned old = xb_add(&bar[XB_XSUB(b.x)], 1u);
        const unsigned gen = old / nloc;
        if (old + 1u == (gen + 1u) * nloc) {
            __builtin_amdgcn_fence(__ATOMIC_RELEASE, "agent");
            asm volatile("s_waitcnt vmcnt(0)" ::: "memory");
            const unsigned og = xb_add(&bar[XB_TOP], 1u);
            const unsigned tg = og / nx;
            if (og + 1u == (tg + 1u) * nx) xb_add(&bar[XB_TOPGEN], 1u);
            else XB_SPIN(xb_ld(&bar[XB_TOPGEN]) == tg, bar);
            __builtin_amdgcn_fence(__ATOMIC_ACQUIRE, "agent");
            xb_add(&bar[XB_XGEN(b.x)], 1u);
            asm volatile("s_waitcnt vmcnt(0)" ::: "memory");
        } else {
            XB_SPIN(xb_ld(&bar[XB_XGEN(b.x)]) == gen, bar);
            __builtin_amdgcn_fence(__ATOMIC_ACQUIRE, "agent");
            asm volatile("s_waitcnt vmcnt(0)" ::: "memory");
        }
    }
    __syncthreads();
}

__device__ __forceinline__ void cvt_item(const float* src, int K, int Nsrc, bf16_t* dst, int Kp, int Nd, int type, const float* g, const float* b, cfix_t* c1, cfix_t* c2, int item, float* scr, int lane) {
    const int nblk = Nd / 32, kb = item / nblk, nb = item % nblk, k0 = 64 * kb, n0 = 32 * nb;
    int sc = n0; bool valid = true;
    const int pn = n0 >> 8, bj = (n0 >> 7) & 1, cc = n0 & 127;
    if (type == 0) { const int gcol = 128 * pn + cc; valid = gcol < DFF; sc = bj ? DFF + gcol : gcol; }
    else if (type == 2) {
        if (pn == 0 || pn >= 7) sc = n0;
        else if (pn <= 2) sc = 256 + 256 * bj + 128 * (pn - 1) + cc;
        else { const int base = pn <= 4 ? 768 : 1280, head = 2 * ((pn - 3) & 1) + (cc >> 6); sc = base + 128 * head + 64 * bj + (cc & 63); }
    }
    float a1 = 0.f, a2 = 0.f;
    float vv[32];
#pragma unroll
    for (int i = 0; i < 32; ++i) { const int k = k0 + 2 * i + (lane >> 5); vv[i] = (valid && k < K) ? src[(size_t)k * Nsrc + sc + (lane & 31)] : 0.f; }
#pragma unroll
    for (int i = 0; i < 32; ++i) {
        const int kk = 2 * i + (lane >> 5), k = k0 + kk;
        float v = vv[i];
        if (g) { a2 += b[k] * v; v *= g[k]; a1 += bf2f(f2bf(v)); }
        scr[kk * 33 + (lane & 31)] = v;
    }
    if (g) { a1 += shfl_x(a1, lane, 32); a2 += shfl_x(a2, lane, 32); if (lane < 32) { atomicAdd((unsigned long long*)(c1 + n0 + lane), (unsigned long long)(cfix_t)llrintf(a1 * 4294967296.0f)); atomicAdd((unsigned long long*)(c2 + n0 + lane), (unsigned long long)(cfix_t)llrintf(a2 * 4294967296.0f)); } }
    asm volatile("s_waitcnt lgkmcnt(0)" ::: "memory");
    const int c = lane & 7;
#pragma unroll
    for (int j = 0; j < 4; ++j) { const int n = (lane >> 3) + 8 * j; const float* s = scr + (8 * c) * 33 + n;
        u32x4 o; o.x = cvt_pk_bf16(s[0 * 33], s[1 * 33]); o.y = cvt_pk_bf16(s[2 * 33], s[3 * 33]); o.z = cvt_pk_bf16(s[4 * 33], s[5 * 33]); o.w = cvt_pk_bf16(s[6 * 33], s[7 * 33]);
        *(u32x4*)(dst + (size_t)(n0 + n) * Kp + k0 + 8 * c) = o; }
    asm volatile("s_waitcnt lgkmcnt(0)" ::: "memory");
}
__device__ __forceinline__ void cvt_job(const float* src, int K, int Nsrc, bf16_t* dst, int Kp, int Nd, int type, const float* g, const float* b, cfix_t* c1, cfix_t* c2, float* scr, int gw, int NGW, int lane) {
    const int nitems = (Kp / 64) * (Nd / 32);
    for (int it = gw; it < nitems; it += NGW) cvt_item(src, K, Nsrc, dst, Kp, Nd, type, g, b, c1, c2, it, scr, lane);
}

struct Args { const float* in[20]; float* out; unsigned char* ws; int ph_lo, ph_hi, use_cg, pad; };

#define INP(i) ((const float*)(((unsigned long long)(unsigned)__builtin_amdgcn_readfirstlane((int)ptab[2 * (i) + 1]) << 32) | (unsigned long long)(unsigned)__builtin_amdgcn_readfirstlane((int)ptab[2 * (i)])))
template <bool PRO, bool MID, int MASK>
__device__ __forceinline__ void run_phase(const Args& a, unsigned char* smem, volatile LAS unsigned* ptab_in, const int ph, const int G, const int NGW, const int NTH, const int wave_s) {
        unsigned pt_ = (unsigned)(unsigned long long)ptab_in; asm volatile("" : "+s"(pt_));
        volatile LAS unsigned* ptab = (volatile LAS unsigned*)(unsigned long long)pt_;
        unsigned char* ws = a.ws; float* zf = a.out;
        asm volatile("" : "+s"(ws), "+s"(zf));
        int bid = blockIdx.x;
        asm volatile("" : "+s"(bid));
        const int wave = wave_s;
#define TID_SETUP int tid = wave_s * 64 + lane_id_v(); const int lane = tid & 63, gw = bid * 8 + wave, gtid = bid * 512 + tid; (void)lane; (void)gw; (void)gtid;
        const float* x = INP(0); const float* meta = INP(1);
        float* zfm = (float*)(ws + OFF_ZFM);
        float* stats0 = (float*)(ws + OFF_STATS); float* stats1 = (float*)(ws + OFF_STATS + STATS_BYTES);
        float* rope = (float*)(ws + OFF_ROPE);
        cfix_t* cvec = (cfix_t*)(ws + OFF_CVEC);
        bf16_t* zb = (bf16_t*)(ws + OFF_ZB);
        bf16_t* Gb = (bf16_t*)(ws + OFF_G);
        bf16_t *XP = (bf16_t*)(ws + OFF_XP), *U = (bf16_t*)(ws + OFF_U), *Q = (bf16_t*)(ws + OFF_Q), *Kb = (bf16_t*)(ws + OFF_K), *K2 = (bf16_t*)(ws + OFF_K2), *V = (bf16_t*)(ws + OFF_V), *SG = (bf16_t*)(ws + OFF_SG);
        bf16_t* YC = (bf16_t*)(ws + OFF_YCAT); bf16_t* ST = (bf16_t*)(ws + OFF_ST);
        bf16_t* WA13 = (bf16_t*)(ws + OFF_WA); bf16_t* WA2 = (bf16_t*)(ws + OFF_WA + W13_BYTES);
        bf16_t* WB13 = (bf16_t*)(ws + OFF_WB); bf16_t* WB2 = (bf16_t*)(ws + OFF_WB + W13_BYTES);
        const float* ln_g = INP(18); const float* ln_b = INP(19);
        float* scr = (float*)(smem + wave * 8704);
        if (PRO && (MASK & 1) && ph == 0) {
            TID_SETUP
            cvt_job(INP(4), 1024, 2 * DFF, WA13, 1024, NUP, 0, INP(2), INP(3), cvec + 0, cvec + 5632, scr, gw, NGW, lane);
            cvt_job(INP(5), DFF, 1024, WA2, GW, 1024, 1, nullptr, nullptr, nullptr, nullptr, scr, gw, NGW, lane);
            for (int l = 0; l < 2; ++l) {
                cvt_job(INP(13) + (size_t)l * 65536, 256, 256, (bf16_t*)(ws + OFF_PW) + (size_t)l * 65536, 256, 256, 1, nullptr, nullptr, nullptr, nullptr, scr, gw, NGW, lane);
                bf16_t* ppt = (bf16_t*)(ws + OFF_PP) + (size_t)l * 65536; const float* pw = INP(7) + (size_t)l * 16384; const float* psc = INP(8) + l * 256;
                for (int idx = gtid; idx < 65536; idx += NTH) { const int n = idx >> 8, kk = idx & 255;
                    ppt[idx] = (bf16_t)((kk >> 6) == (n >> 6) ? f2bf(pw[(size_t)((n >> 6) * 64 + (kk & 63)) * 64 + (n & 63)] * psc[n]) : 0u); }
            }
            for (int r0 = gw; r0 < T; r0 += 2 * NGW) {
                const int r1 = r0 + NGW; const bool two = r1 < T; const int r1c = two ? r1 : r0;
                const float* s0 = r0 < TM ? x + (size_t)r0 * 1024 : meta + (size_t)((r0 - TM) & 15) * 1024;
                const float* s1 = r1c < TM ? x + (size_t)r1c * 1024 : meta + (size_t)((r1c - TM) & 15) * 1024;
                f32x4 v[4], w4[4]; float sa = 0.f, ssa = 0.f, sb = 0.f, ssb = 0.f;
#pragma unroll
                for (int j = 0; j < 4; ++j) { v[j] = ((const f32x4*)s0)[lane + 64 * j]; w4[j] = ((const f32x4*)s1)[lane + 64 * j]; }
#pragma unroll
                for (int j = 0; j < 4; ++j) { sa += (v[j].x + v[j].y) + (v[j].z + v[j].w); ssa += (v[j].x * v[j].x + v[j].y * v[j].y) + (v[j].z * v[j].z + v[j].w * v[j].w);
                                              sb += (w4[j].x + w4[j].y) + (w4[j].z + w4[j].w); ssb += (w4[j].x * w4[j].x + w4[j].y * w4[j].y) + (w4[j].z * w4[j].z + w4[j].w * w4[j].w); }
#pragma unroll
                for (int o = 1; o < 64; o <<= 1) { sa += shfl_x(sa, lane, o); ssa += shfl_x(ssa, lane, o); sb += shfl_x(sb, lane, o); ssb += shfl_x(ssb, lane, o); }
#pragma unroll
                for (int j = 0; j < 4; ++j) { u32x2 w; w.x = cvt_pk_bf16(v[j].x, v[j].y); w.y = cvt_pk_bf16(v[j].z, v[j].w); ((u32x2*)(zb + (size_t)r0 * 1024))[lane + 64 * j] = w; }
                if (lane < 16) ((f32x2*)(stats0 + (size_t)r0 * 32))[lane] = lane == 0 ? (f32x2){sa, ssa} : (f32x2){0.f, 0.f};
                if (two) {
#pragma unroll
                    for (int j = 0; j < 4; ++j) { u32x2 w; w.x = cvt_pk_bf16(w4[j].x, w4[j].y); w.y = cvt_pk_bf16(w4[j].z, w4[j].w); ((u32x2*)(zb + (size_t)r1 * 1024))[lane + 64 * j] = w; }
                    if (lane < 16) ((f32x2*)(stats0 + (size_t)r1 * 32))[lane] = lane == 0 ? (f32x2){sb, ssb} : (f32x2){0.f, 0.f};
                }
            }
            for (int idx = gtid; idx < LSEQ * 64; idx += NTH) {
                const int t = idx >> 6, i = idx & 63;
                const double inv = exp2(-(double)i * (13.287712379549449 / 64.0));
                double sn, cs; sincos((double)t * inv, &sn, &cs);
                ((f32x2*)rope)[idx] = (f32x2){(float)cs, (float)sn};
            }
        } else if (PRO && (MASK & 1) && ph == -1) {
            TID_SETUP
            const float* fg = ln_g + 5 * 1024; const float* fb = ln_b + 5 * 1024;
            for (int r = gw; r < TM; r += NGW) {
                f32x4* p = (f32x4*)(zf + (size_t)r * 1024); f32x4 v[4]; float s = 0.f;
#pragma unroll
                for (int j = 0; j < 4; ++j) { v[j] = p[lane + 64 * j]; s += (v[j].x + v[j].y) + (v[j].z + v[j].w); }
                const float mean = wave_sum(s, lane) * (1.f / 1024.f); float s2 = 0.f;
#pragma unroll
                for (int j = 0; j < 4; ++j) { v[j] = v[j] - mean; s2 += (v[j].x * v[j].x + v[j].y * v[j].y) + (v[j].z * v[j].z + v[j].w * v[j].w); }
                const float rstd = rsqrtf(wave_sum(s2, lane) * (1.f / 1024.f) + LN_EPS);
#pragma unroll
                for (int j = 0; j < 4; ++j) { const f32x4 gg = ((const f32x4*)fg)[lane + 64 * j], bb = ((const f32x4*)fb)[lane + 64 * j]; p[lane + 64 * j] = v[j] * rstd * gg + bb; }
            }
        } else if (MID) {
            const int q = ph - 1, l = q / 9, k = q - 9 * l;
            const int par = (3 * l + (k > 1 ? 1 : 0) + (k > 6 ? 1 : 0)) & 1;
            const float* sprev = par ? stats1 : stats0; float* snew = par ? stats0 : stats1;
            cfix_t* cv = cvec + l * 28160;
            bf16_t* win = (bf16_t*)(ws + (l ? OFF_WIO1 : OFF_WIO0)); bf16_t* wout = (bf16_t*)(ws + (l ? OFF_WIO1 : OFF_WIO0) + WIN_BYTES);
            if ((MASK & 2) && (k == 0 || k == 7)) {
                TID_SETUP
                pg8::Gemm g{zb, k == 0 ? WA13 : WB13, 1024}; pg8::StaticOrder S; S.init(TM, NUP, G, bid);
                const LAS float* ctab = (const LAS float*)((LAS unsigned char*)smem + CTAB_OFF);
                {
                    const cfix_t* cc1 = cv + (k == 0 ? 0 : 16896); const cfix_t* cc2 = cv + (k == 0 ? 5632 : 22528);
                    for (int i = 0; i < 6; ++i) { pg8::Unit uu; if (!S.next(i, uu)) break;
                        ((LAS float*)ctab)[i * 512 + tid] = cfix2f((tid < 256 ? cc1 : cc2)[uu.pn * 256 + (tid & 255)]); }
                    __syncthreads();
                }
                EpiUp E{sprev, cv + (k == 0 ? 0 : 16896), cv + (k == 0 ? 5632 : 22528), ws, ctab};
                pg8::gemm_phase<EpiUp>((LAS unsigned char*)smem, g, S, E, tid);
                tail_units<EpiUp>(smem, zb + (size_t)TM * 1024, g.Bt, 1024, NUP / 64, S.nwg % G, E, wave_s * 64 + lane_id_v(), bid);
                if (bid >= 128 && (k == 0 || (l == 0 && k == 7))) {
                    const int gw2 = (bid - 128) * 8 + wave, NGW2 = 128 * 8; const int ln2 = lane_id_v();
                    if (k == 0) {
                        cvt_job(INP(16) + (size_t)l * 1024 * 2 * DFF, 1024, 2 * DFF, WB13, 1024, NUP, 0, ln_g + (3 * l + 1) * 1024, ln_b + (3 * l + 1) * 1024, cv + 16896, cv + 22528, scr, gw2, NGW2, ln2);
                        cvt_job(INP(17) + (size_t)l * DFF * 1024, DFF, 1024, WB2, GW, 1024, 1, nullptr, nullptr, nullptr, nullptr, scr, gw2, NGW2, ln2);
                        if (l == 0) {
                            cvt_job(INP(6), 1024, DIN, win, 1024, DIN, 2, ln_g, ln_b, cv + 11264, cv + 14080, scr, gw2, NGW2, ln2);
                            cvt_job(INP(15), 1024, 1024, wout, 1024, 1024, 1, nullptr, nullptr, nullptr, nullptr, scr, gw2, NGW2, ln2);
                        }
                    } else {
                        cvt_job(INP(4) + (size_t)1024 * 2 * DFF, 1024, 2 * DFF, WA13, 1024, NUP, 0, ln_g + 2 * 1024, ln_b + 2 * 1024, cvec + 28160 + 0, cvec + 28160 + 5632, scr, gw2, NGW2, ln2);
                        cvt_job(INP(5) + (size_t)DFF * 1024, DFF, 1024, WA2, GW, 1024, 1, nullptr, nullptr, nullptr, nullptr, scr, gw2, NGW2, ln2);
                    }
                }
            } else if ((MASK & 4) && (k == 1 || k == 6 || k == 8)) {
                TID_SETUP
                const bool isout = k == 6;
                const int lni = k == 1 ? (l == 0 ? -1 : 2) : (k == 6 ? 3 * l + 0 : 3 * l + 1);
                const float* lg = lni < 0 ? INP(2) : ln_g + lni * 1024; const float* lb = lni < 0 ? INP(3) : ln_b + lni * 1024;
                const bf16_t* Amat = isout ? YC : Gb; const int Kd = isout ? 1024 : GW;
                const bf16_t* Bt = isout ? wout : (k == 1 ? WA2 : WB2);
                pg8::Gemm g{Amat, Bt, Kd}; pg8::StaticOrder S; S.init(TM, 1024, G, bid);
                const LAS float* ctab = (const LAS float*)((LAS unsigned char*)smem + CTAB_OFF);
                {
                    pg8::Unit uu; if (S.next(0, uu)) { const int cc = uu.pn * 256 + (tid & 255);
                        ((LAS float*)ctab)[tid] = (tid < 256 ? lg : lb)[cc]; ((LAS float*)ctab)[512 + tid] = (tid < 256 ? ln_g + 5 * 1024 : ln_b + 5 * 1024)[cc]; }
                    __syncthreads();
                }
                EpiRes E{sprev, snew, lg, lb, zf, ws, isout ? 1.0f : 0.5f,
                         (l == 1 && k == 8) ? 1 : 0, ln_g + 5 * 1024, ln_b + 5 * 1024, (unsigned*)(ws + OFF_CTL + 14336), ctab};
                pg8::gemm_phase<EpiRes>((LAS unsigned char*)smem, g, S, E, tid);
                if (!E.fin) tail_units<EpiRes>(smem, Amat + (size_t)TM * Kd, Bt, Kd, 16, S.nwg % G, E, wave_s * 64 + lane_id_v(), bid);
            } else if ((MASK & 8) && k == 2) {
                TID_SETUP
                pg8::Gemm g{zb, win, 1024}; pg8::StaticOrder S; S.init(TM, DIN, G, bid);
                const LAS float* ctab = (const LAS float*)((LAS unsigned char*)smem + CTAB_OFF);
                {
                    const cfix_t* cc1 = cv + 11264; const cfix_t* cc2 = cv + 14080;
                    for (int i = 0; i < 3; ++i) { pg8::Unit uu; if (!S.next(i, uu)) break;
                        ((LAS float*)ctab)[i * 512 + tid] = cfix2f((tid < 256 ? cc1 : cc2)[uu.pn * 256 + (tid & 255)]); }
                    __syncthreads();
                }
                EpiIn E{sprev, cv + 11264, cv + 14080, ws, ctab};
                pg8::gemm_phase<EpiIn>((LAS unsigned char*)smem, g, S, E, tid);
                tail_units<EpiIn>(smem, zb + (size_t)TM * 1024, win, 1024, DIN / 64, S.nwg % G, E, wave_s * 64 + lane_id_v(), bid);
                if (l == 0 && bid >= 192) {
                    const int gw2 = (bid - 192) * 8 + wave, NGW2 = 64 * 8; const int ln2 = lane_id_v();
                    cvt_job(INP(6) + (size_t)1024 * DIN, 1024, DIN, (bf16_t*)(ws + OFF_WIO1), 1024, DIN, 2, ln_g + 3 * 1024, ln_b + 3 * 1024, cvec + 28160 + 11264, cvec + 28160 + 14080, scr, gw2, NGW2, ln2);
                    cvt_job(INP(15) + (size_t)1024 * 1024, 1024, 1024, (bf16_t*)(ws + OFF_WIO1 + WIN_BYTES), 1024, 1024, 1, nullptr, nullptr, nullptr, nullptr, scr, gw2, NGW2, ln2);
                }
            } else if ((MASK & 16) && k == 3) {
                TID_SETUP
                const bf16_t* PWT = (const bf16_t*)(ws + OFF_PW) + (size_t)l * 65536; const bf16_t* PPT = (const bf16_t*)(ws + OFF_PP) + (size_t)l * 65536;
                const float* dw = INP(9) + (size_t)l * 31 * 256; const float* db = INP(10) + l * 256;
                const float* cg_ = INP(11) + l * 256; const float* cb_ = INP(12) + l * 256;
                constexpr int NCV = 258, NPL = 258, NKV = 1024;
                for (int j = 0; j < 7; ++j) {
                    int it = -1; bool pair = false;
                    if (j == 0) it = bid;
                    else if (j == 1) { if (bid < 2) it = 256 + bid; }
                    else if (j == 2) it = NCV + bid;
                    else if (j == 3) { if (bid >= 2 && bid < 4) it = NCV + 256 + (bid - 2); }
                    else if (j < 6) { pair = true; if (bid >= 4) it = NCV + NPL + 4 * (bid - 4) + 2 * (j - 4); else if (bid >= 2 && j == 4) it = NCV + NPL + 1008 + 2 * (bid - 2); }
                    else { if (bid >= 4 && bid < 16) it = NCV + NPL + 1012 + (bid - 4); }
                    if (it < 0) continue;
                    asm volatile("" : "+v"(tid));
                    if (it < NCV) conv_item(smem, U, PWT, dw, db, cg_, cb_, YC, it / 129, it % 129, tid);
                    else if (it < NCV + NPL) pool_item(smem, XP, PPT, YC, (it - NCV) / 129, (it - NCV) % 129, tid);
                    else { const int kk = it - NCV - NPL; if (pair) kv_item<2>(smem, Kb, V, ST, kk >> 7, kk & 127, tid); else kv_item<1>(smem, Kb, V, ST, kk >> 7, kk & 127, tid); }
                }
            } else if ((MASK & 64) && k == 4) {
                TID_SETUP
                {
                    const int d = gtid & 127, e = (gtid >> 7) & 127, bh = gtid >> 14, h = bh & 3;
                    const float g64 = exp2f(64.f * log2_gamma(h));
                    bf16_t* p = ST + (size_t)bh * NCHUNK * 16384 + e * 128 + d;
                    float Sv = 0.f;
#pragma unroll 1
                    for (int n0 = 0; n0 < NCHUNK - 1; n0 += 32) {
                        unsigned short kvb[32];
#pragma unroll
                        for (int j = 0; j < 32; ++j) kvb[j] = p[(size_t)(n0 + j) * 16384];
#pragma unroll
                        for (int j = 0; j < 32; ++j) { p[(size_t)(n0 + j) * 16384] = (bf16_t)f2bf(Sv); Sv = g64 * Sv + bf2f(kvb[j]); }
                    }
                    p[(size_t)(NCHUNK - 1) * 16384] = (bf16_t)f2bf(Sv);
                }
            } else if ((MASK & 32) && k == 5) {
                TID_SETUP
                const float* gng = INP(14) + l * 512;
                RetRegs R;
                { const int bh0 = bid < 1024 ? (bid >> 7) : (bid - 1024), n0_ = bid < 1024 ? 1 + (bid & 127) : 0; ret_load(R, Q, Kb, V, ST, SG, bh0, n0_, tid); }
                for (int it = bid; it < 1032; it += G) {
                    const int bh = it < 1024 ? (it >> 7) : (it - 1024), n = it < 1024 ? 1 + (it & 127) : 0;
                    const int itn = it + G; const bool hn = itn < 1032;
                    const int nbh = itn < 1024 ? (itn >> 7) : (itn - 1024), nn = itn < 1024 ? 1 + (itn & 127) : 0;
                    ret_item(smem, R, Q, Kb, V, ST, SG, gng, YC, bh, n, hn, hn ? nbh : bh, hn ? nn : n, tid);
                }
            }
        }
}

template <int MASK>
__global__ void __launch_bounds__(512, 2) mk_fwd(Args a) {
    extern __shared__ __attribute__((aligned(16))) unsigned char smem[];
    constexpr int G = GRID, NGW = G * 8, NTH = G * 512;
    volatile LAS unsigned* misc = (volatile LAS unsigned*)((LAS unsigned char*)smem + MISC_OFF);
    if (threadIdx.x < 64) misc[threadIdx.x] = 0u;
    volatile LAS unsigned* ptab = misc + 64;
    if (threadIdx.x == 0) {
#pragma unroll
        for (int i = 0; i < 20; ++i) { const unsigned long long p = (unsigned long long)a.in[i]; ptab[2 * i] = (unsigned)p; ptab[2 * i + 1] = (unsigned)(p >> 32); }
    }
    __syncthreads();
    XcdBarrier bar = xcd_barrier_post((unsigned*)(a.ws + OFF_CTL), misc + 8);
    const int wave_s = __builtin_amdgcn_readfirstlane((int)(threadIdx.x >> 6));
    if (a.ph_lo <= 0 && a.ph_hi > 0) {
        run_phase<true, false, MASK>(a, smem, ptab, 0, G, NGW, NTH, wave_s);
        if (a.ph_hi > 1) { if (a.use_cg) cg::this_grid().sync(); else xcd_barrier(bar, wave_s); }
    }
    for (int ph = (a.ph_lo > 1 ? a.ph_lo : 1); ph < (a.ph_hi < NPH ? a.ph_hi : NPH); ++ph) {
        if (ph > 1 && ph > a.ph_lo) xcd_barrier(bar, wave_s);
        run_phase<false, true, MASK>(a, smem, ptab, ph, G, NGW, NTH, wave_s);
    }
}

template <int MASK> static void launch_plain(const Args& a, int grid, hipStream_t stream) {
    static bool attr = false;
    if (!attr) { (void)hipFuncSetAttribute((const void*)mk_fwd<MASK>, hipFuncAttributeMaxDynamicSharedMemorySize, LDS_BYTES); attr = true; }
    hipLaunchKernelGGL(mk_fwd<MASK>, dim3(grid), dim3(512), LDS_BYTES, stream, a);
}
extern "C" void kernel_launch(void* const* d_in, const int* in_sizes, int n_in, void* d_out, int out_size, void* d_ws, size_t ws_size, hipStream_t stream) {
    static int grid = 0;
    if (grid == 0) {
        if (n_in != 20 || out_size != TM * D || ws_size < WS_END) { fprintf(stderr, "kernel_launch: unexpected shapes (n_in %d, out %d, ws %zu, need %zu)\n", n_in, out_size, ws_size, (size_t)WS_END); grid = -1; return; }
        int dev = 0, cus = 0;
        (void)hipGetDevice(&dev); (void)hipDeviceGetAttribute(&cus, hipDeviceAttributeMultiprocessorCount, dev);
#if ONE_LAUNCH
        if (hipFuncSetAttribute((const void*)mk_fwd<127>, hipFuncAttributeMaxDynamicSharedMemorySize, LDS_BYTES) != hipSuccess) { fprintf(stderr, "kernel_launch: hipFuncSetAttribute failed\n"); grid = -1; return; }
#endif
        grid = GRID;
        if (cus != GRID) fprintf(stderr, "kernel_launch: warning: %d CUs, kernel built for %d\n", cus, GRID);
    }
    if (grid < 0) return;
    (void)hipMemsetAsync(d_ws, 0, ZERO_BYTES, stream);
    Args a{};
    for (int i = 0; i < 20; ++i) a.in[i] = (const float*)d_in[i];
    a.out = (float*)d_out; a.ws = (unsigned char*)d_ws; a.use_cg = 0; a.pad = 0;
#if ONE_LAUNCH
    a.ph_lo = 0; a.ph_hi = NPH;
    void* args[] = {&a};
    hipError_t e = hipLaunchCooperativeKernel((const void*)mk_fwd<127>, dim3(grid), dim3(512), args, LDS_BYTES, stream);
    if (e != hipSuccess) fprintf(stderr, "cooperative launch failed: %s (grid %d)\n", hipGetErrorString(e), grid);
#if PROBE_SET
    {
        static bool attr = false;
        if (!attr) { (void)hipFuncSetAttribute((const void*)mk_fwd<127>, hipFuncAttributeMaxDynamicSharedMemorySize, LDS_BYTES); attr = true; }
        for (int ph = 1; ph < NPH; ++ph) {
            const int k = (ph - 1) % 9;
            const bool sel = PROBE_SET == 1 ? (k == 0 || k == 7 || k == 2) : PROBE_SET == 2 ? (k == 3 || k == 4 || k == 5) : PROBE_SET == 3 ? (k == 0 || k == 7) : PROBE_SET == 4 ? (k == 3) : PROBE_SET == 5 ? (k == 4) : (k == 5);
            if (!sel) continue;
            a.ph_lo = ph; a.ph_hi = ph + 1;
            hipLaunchKernelGGL(mk_fwd<127>, dim3(grid), dim3(512), LDS_BYTES, stream, a);
        }
    }
#endif
#else
    for (int ph = 0; ph < NPH; ++ph) {
        a.ph_lo = ph; a.ph_hi = ph + 1;
        if (ph == 0) { launch_plain<1>(a, grid, stream); continue; }
        const int k = (ph - 1) % 9;
        if (k == 0 || k == 7) launch_plain<2>(a, grid, stream);
        else if (k == 1 || k == 6 || k == 8) launch_plain<4>(a, grid, stream);
        else if (k == 2) launch_plain<8>(a, grid, stream);
        else if (k == 3) launch_plain<16>(a, grid, stream);
        else if (k == 4) launch_plain<64>(a, grid, stream);
        else launch_plain<32>(a, grid, stream);
    }
#endif
}
```

```cpp
#include <hip/hip_runtime.h>
#include <hip/hip_cooperative_groups.h>
#include <cstdio>
#include <cstdint>
namespace cg = cooperative_groups;

#define LAS __attribute__((address_space(3)))
typedef unsigned short bf16_t;
typedef short bf16x8 __attribute__((ext_vector_type(8)));
typedef float f32x4 __attribute__((ext_vector_type(4)));
typedef float f32x16 __attribute__((ext_vector_type(16)));
typedef float f32x2 __attribute__((ext_vector_type(2)));
typedef unsigned u32x4 __attribute__((ext_vector_type(4)));
typedef unsigned u32x2 __attribute__((ext_vector_type(2)));

#ifndef EN_PRO
#define EN_PRO 1
#endif
#ifndef EN_UP
#define EN_UP 1
#endif
#ifndef EN_RES
#define EN_RES 1
#endif
#ifndef EN_IN
#define EN_IN 1
#endif
#ifndef EN_M1
#define EN_M1 1
#endif
#ifndef EN_M2
#define EN_M2 1
#endif
#ifndef PROBE_SET
#define PROBE_SET 0
#endif
#ifndef ONE_LAUNCH
#define ONE_LAUNCH 1
#endif

constexpr int D = 1024, SEQ = 8192, NMETA = 16, LSEQ = SEQ + NMETA, NB = 2;
constexpr int TM = NB * SEQ;
constexpr int T = TM + NB * NMETA;
constexpr int DFF = 2752, GW = 2816, NUP = 5632, DIN = 2816;
constexpr int NCHUNK = 129;
constexpr float ALPHA = 1.41421356237309515f;
constexpr float LN_EPS = 1e-5f;
constexpr int NPH = 19;
constexpr int GRID = 256;

constexpr size_t OFF_CTL = 0;
constexpr size_t OFF_CVEC = 16384;
constexpr size_t ZERO_BYTES = 524288;
constexpr size_t OFF_ZFM = 524288;
constexpr size_t OFF_STATS = OFF_ZFM + 32 * 1024 * 4;
constexpr size_t STATS_BYTES = (size_t)T * 32 * 4;
constexpr size_t OFF_ROPE = OFF_STATS + 2 * STATS_BYTES;
constexpr size_t OFF_PW = OFF_ROPE + (size_t)LSEQ * 64 * 8;
constexpr size_t OFF_PP = OFF_PW + 2 * 131072;
constexpr size_t OFF_WA = OFF_PP + 2 * 131072;
constexpr size_t W13_BYTES = (size_t)NUP * 1024 * 2, W2_BYTES = (size_t)1024 * GW * 2;
constexpr size_t OFF_WB = OFF_WA + W13_BYTES + W2_BYTES;
constexpr size_t OFF_WIO0 = OFF_WB + W13_BYTES + W2_BYTES;
constexpr size_t WIN_BYTES = (size_t)DIN * 1024 * 2, WOUT_BYTES = (size_t)1024 * 1024 * 2;
constexpr size_t OFF_WIO1 = OFF_WIO0 + WIN_BYTES + WOUT_BYTES;
constexpr size_t OFF_ZB = OFF_WIO1 + WIN_BYTES + WOUT_BYTES;
constexpr size_t OFF_R = OFF_ZB + (size_t)T * 1024 * 2;
constexpr size_t OFF_G = OFF_R;
constexpr size_t OFF_XP = OFF_R;
constexpr size_t OFF_U = OFF_XP + (size_t)T * 256 * 2;
constexpr size_t OFF_Q = OFF_U + (size_t)T * 256 * 2;
constexpr size_t OFF_K = OFF_Q + (size_t)T * 512 * 2;
constexpr size_t OFF_K2 = OFF_K + (size_t)T * 512 * 2;
constexpr size_t OFF_V = OFF_K2 + (size_t)T * 512 * 2;
constexpr size_t OFF_SG = OFF_V + (size_t)T * 512 * 2;
constexpr size_t OFF_YCAT = OFF_SG + (size_t)T * 512 * 2;
constexpr size_t OFF_ST = OFF_YCAT + (size_t)T * 1024 * 2;
constexpr size_t WS_END = OFF_ST + (size_t)NB * 4 * NCHUNK * 16384 * 2;
static_assert(OFF_G + (size_t)T * GW * 2 <= WS_END, "G fits");
static_assert(WS_END <= (size_t)268435456, "workspace budget");

constexpr int LDS_BYTES = 147456;
constexpr int MISC_OFF = 131072;
constexpr int CTAB_OFF = MISC_OFF + 1024;
typedef short v4i16_t __attribute__((ext_vector_type(4)));

__device__ __forceinline__ unsigned f2bf(float f) { unsigned u = __float_as_uint(f); return (u + 0x7fffu + ((u >> 16) & 1u)) >> 16; }
__device__ __forceinline__ float bf2f(unsigned h) { return __uint_as_float(h << 16); }
typedef __bf16 bf16x2_t __attribute__((ext_vector_type(2)));
__device__ __forceinline__ unsigned cvt_pk_bf16(float lo, float hi) { const f32x2 v = {lo, hi}; const bf16x2_t r = __builtin_convertvector(v, bf16x2_t); return __builtin_bit_cast(unsigned, r); }
__device__ __forceinline__ int lane_id_v() { int l; asm volatile("v_mbcnt_lo_u32_b32 %0, -1, 0\n\tv_mbcnt_hi_u32_b32 %0, -1, %0" : "=v"(l)); return l; }
__device__ __forceinline__ float shfl_i(float v, int src) { return __builtin_bit_cast(float, __builtin_amdgcn_ds_bpermute(src << 2, __builtin_bit_cast(int, v))); }
__device__ __forceinline__ float shfl_x(float v, int lane, int m) { return shfl_i(v, lane ^ m); }
__device__ __forceinline__ float wave_sum(float v, int lane) {
#pragma unroll
    for (int o = 1; o < 64; o <<= 1) v += shfl_x(v, lane, o);
    return v;
}
typedef long long cfix_t;
__device__ __forceinline__ float cfix2f(cfix_t v) { return (float)((double)v * (1.0 / 4294967296.0)); }
__device__ __forceinline__ f32x4 ldc4(const cfix_t* p) { const u32x4 a = *(const u32x4*)p, b = *(const u32x4*)(p + 2);
    return (f32x4){cfix2f((cfix_t)(((unsigned long long)a.y << 32) | a.x)), cfix2f((cfix_t)(((unsigned long long)a.w << 32) | a.z)), cfix2f((cfix_t)(((unsigned long long)b.y << 32) | b.x)), cfix2f((cfix_t)(((unsigned long long)b.w << 32) | b.z))}; }
__device__ __forceinline__ float fast_sigmoid(float x) { return __builtin_amdgcn_rcpf(1.0f + __builtin_amdgcn_exp2f(-1.4426950408889634f * x)); }
__device__ __forceinline__ float silu_f(float x) { return x * fast_sigmoid(x); }
__device__ __forceinline__ int tok_row(int b, int t) { return t < NMETA ? TM + NMETA * b + t : SEQ * b + t - NMETA; }
__device__ __forceinline__ void row_bt(int r, int& b, int& t) { if (r < TM) { b = r >> 13; t = (r & 8191) + NMETA; } else { const int m = r - TM; b = m >> 4; t = m & 15; } }
__device__ __forceinline__ float log2_gamma(int h) { return __log2f(1.0f - exp2f(-5.0f - (float)h)); }
__device__ __forceinline__ void stat_finish(float s, float ss, float& mu, float& rs) { mu = s * (1.f / 1024.f); const float var = ss * (1.f / 1024.f) - mu * mu; rs = rsqrtf(fmaxf(var, 0.f) + LN_EPS); }
__device__ __forceinline__ void load_row_stat(const float* stats, int r, float& mu, float& rs) {
    const f32x4* p = (const f32x4*)(stats + (size_t)r * 32); float s = 0.f, ss = 0.f;
#pragma unroll
    for (int k = 0; k < 8; ++k) { const f32x4 v = p[k]; s += v.x + v.z; ss += v.y + v.w; }
    stat_finish(s, ss, mu, rs);
}

struct UnitStats {
    float mu0, rs0, mu1, rs1;
    __device__ __forceinline__ void load(const float* stats, int rowbase, int lane) { load_row_stat(stats, rowbase + lane, mu0, rs0); load_row_stat(stats, rowbase + 128 + lane, mu1, rs1); }
    __device__ __forceinline__ void get(int ai, int m, int fr, float& mu, float& rs) const { const int src = 16 * m + fr; mu = shfl_i(ai ? mu1 : mu0, src); rs = shfl_i(ai ? rs1 : rs0, src); }
};

namespace pg8 {
constexpr int BM = 256, BK = 64, HALF = 128, HTB = HALF * BK * 2, STAGE_BYTES = 8 * HTB, NXCD = 8, WGM = 4;
__host__ __device__ __forceinline__ int lds_byte(int r, int c) { const int st = (r >> 4) * 2 + (c >> 5), rr = r & 15, cc = c & 31, ob = rr * 64 + cc * 2; return st * 1024 + (ob ^ (((ob >> 9) & 1) << 5)); }
__host__ __device__ __forceinline__ void stage_rc(int b, int& R, int& C) { const int st = b / 1024, sb = b % 1024, swz = sb ^ (((sb >> 9) & 1) << 5); R = (st >> 1) * 16 + swz / 64; C = (st & 1) * 32 + (swz % 64) / 2; }
__host__ __device__ __forceinline__ int perm32(int rho) { const int n = rho >> 4, i = rho & 15; return 8 * (i >> 2) + 4 * n + (i & 3); }
struct Unit { int pm, pn; };
struct Gemm { const bf16_t* A; const bf16_t* Bt; int K; };
struct StaticOrder {
    int nM, nN, nwg, G, c;
    __device__ void init(int M, int N, int G_, int c_) { nM = M / BM; nN = N / BM; nwg = nM * nN; G = G_; c = c_; }
    __device__ bool next(int i, Unit& u) const {
        const long L = (long)i * G + c; if (L >= nwg) return false;
        int wgid = (int)L; { const int q = nwg / NXCD, r = nwg % NXCD, xcd = wgid % NXCD, off = wgid / NXCD; wgid = (xcd < r ? xcd * (q + 1) : r * (q + 1) + (xcd - r) * q) + off; }
        const int nig = WGM * nN, gid = wgid / nig, fm = gid * WGM, gsz = (nM - fm) < WGM ? (nM - fm) : WGM;
        u.pm = __builtin_amdgcn_readfirstlane(fm + ((wgid % nig) % gsz)); u.pn = __builtin_amdgcn_readfirstlane((wgid % nig) / gsz); return true;
    }
};

template <class Epi>
__device__ __forceinline__ void gemm_phase(LAS unsigned char* lds, const Gemm g, const StaticOrder& S, const Epi& E, const int tid) {
    const int wid = __builtin_amdgcn_readfirstlane(tid >> 6), lane = tid & 63, wr = wid >> 2, wc = wid & 3, fr = lane & 15, fq = lane >> 4;
    const int K = g.K, nt = K / BK;
    unsigned voffA[2], voffB[2];
#pragma unroll
    for (int i = 0; i < 2; ++i) { int R, C; stage_rc(tid * 16 + i * 8192, R, C); const int Rb = Epi::PERM ? ((R & ~31) + perm32(R & 31)) : R;
        voffA[i] = (unsigned)(R * K + C) * 2u; voffB[i] = (unsigned)(Rb * K + C) * 2u; }
    const size_t kstep = (size_t)(BK * 2);
    const size_t hstep = (size_t)HALF * K * 2;
    const size_t tstep = 2 * hstep;
    const unsigned ldsw = (unsigned)wid * 1024u;
    const int aoff = lds_byte(wr * 64 + fr, fq * 8), boff = lds_byte(wc * 32 + fr, fq * 8);
#define PG8_SA(b, h) (((b) * 2 + (h)) * HTB)
#define PG8_SB(b, h) ((4 + (b) * 2 + (h)) * HTB)
#define PG8_STAGE(bufoff, gbase, voff) do { _Pragma("unroll") for (int _i = 0; _i < 2; ++_i) \
        __builtin_amdgcn_global_load_lds((const unsigned*)((const char*)(gbase) + (voff)[_i]), (LAS unsigned*)(lds + (bufoff) + ldsw + _i * 8192), 16, 0, 0); } while (0)
#define PG8_LDA(dst, b, h) do { _Pragma("unroll") for (int m = 0; m < 4; ++m) _Pragma("unroll") for (int k = 0; k < 2; ++k) dst[m][k] = *(const LAS bf16x8*)(lds + PG8_SA(b, h) + aoff + m * 2048 + k * 1024); } while (0)
#define PG8_LDB(dst, b, h) do { _Pragma("unroll") for (int n = 0; n < 2; ++n) _Pragma("unroll") for (int k = 0; k < 2; ++k) dst[n][k] = *(const LAS bf16x8*)(lds + PG8_SB(b, h) + boff + n * 2048 + k * 1024); } while (0)
#define PG8_MMA(ai, bj, At, Bt) do { __builtin_amdgcn_s_setprio(1); _Pragma("unroll") for (int m = 0; m < 4; ++m) _Pragma("unroll") for (int n = 0; n < 2; ++n) _Pragma("unroll") for (int k = 0; k < 2; ++k) \
        acc[ai][bj][m][n] = __builtin_amdgcn_mfma_f32_16x16x32_bf16(Bt[n][k], At[m][k], acc[ai][bj][m][n], 0, 0, 0); __builtin_amdgcn_s_setprio(0); } while (0)
#define PG8_WAIT_V(n) asm volatile("s_waitcnt vmcnt(" #n ")" ::: "memory")
#define PG8_WAIT_L(n) asm volatile("s_waitcnt lgkmcnt(" #n ")" ::: "memory")
#define PG8_BAR __builtin_amdgcn_s_barrier()
#define PG8_SCHED __builtin_amdgcn_sched_barrier(0)
    Unit cur, nxt; int ui = 0;
    if (!S.next(0, cur)) return;
    UnitStats stn;
    stn.load(E.stats, cur.pm * 256 + wr * 64, lane);
    f32x4 acc[2][2][4][2];
#pragma unroll
    for (int a = 0; a < 2; ++a)
#pragma unroll
        for (int b = 0; b < 2; ++b)
#pragma unroll
            for (int m = 0; m < 4; ++m)
#pragma unroll
                for (int n = 0; n < 2; ++n) acc[a][b][m][n] = (f32x4){0.f, 0.f, 0.f, 0.f};
    bf16x8 At[4][2], B0[2][2], B1[2][2];
    const char* cA = (const char*)g.A + (size_t)cur.pm * tstep; const char* cB = (const char*)g.Bt + (size_t)cur.pn * tstep;
    PG8_STAGE(PG8_SB(0, 0), cB, voffB); PG8_STAGE(PG8_SB(0, 1), cB + hstep, voffB); PG8_STAGE(PG8_SA(0, 0), cA, voffA); PG8_STAGE(PG8_SA(0, 1), cA + hstep, voffA);
    if (wr == 1) PG8_BAR;
    PG8_WAIT_V(2); PG8_BAR;
    PG8_STAGE(PG8_SB(1, 0), cB + kstep, voffB); PG8_STAGE(PG8_SA(1, 0), cA + kstep, voffA); PG8_STAGE(PG8_SB(1, 1), cB + hstep + kstep, voffB);
    PG8_WAIT_V(6); PG8_BAR;
    for (;;) {
        const bool has_next = S.next(ui + 1, nxt);
        const char* nA = has_next ? (const char*)g.A + (size_t)nxt.pm * tstep : cA; const char* nB = has_next ? (const char*)g.Bt + (size_t)nxt.pn * tstep : cB;
        for (int t = 0; t < nt; t += 2) {
            const bool last = (t == nt - 2);
            const char* a1 = cA + (size_t)(t + 1) * kstep;
            const char* a2 = last ? nA : cA + (size_t)(t + 2) * kstep; const char* b2 = last ? nB : cB + (size_t)(t + 2) * kstep;
            const char* a3 = a2 + kstep; const char* b3 = b2 + kstep;
            PG8_LDB(B0, 0, 0); PG8_LDB(B1, 0, 1); PG8_SCHED; PG8_LDA(At, 0, 0); PG8_STAGE(PG8_SA(1, 1), a1 + hstep, voffA);
            PG8_WAIT_V(8); PG8_WAIT_L(0); PG8_BAR; PG8_MMA(0, 0, At, B0); PG8_MMA(0, 1, At, B1); PG8_BAR; PG8_SCHED;
            PG8_LDA(At, 0, 1); PG8_STAGE(PG8_SB(0, 0), b2, voffB); PG8_STAGE(PG8_SB(0, 1), b2 + hstep, voffB); PG8_STAGE(PG8_SA(0, 0), a2, voffA);
            PG8_WAIT_V(8); PG8_WAIT_L(0); PG8_BAR; PG8_MMA(1, 0, At, B0); PG8_MMA(1, 1, At, B1); PG8_BAR; PG8_SCHED;
            PG8_LDB(B0, 1, 0); PG8_LDB(B1, 1, 1); PG8_SCHED; PG8_LDA(At, 1, 0); PG8_STAGE(PG8_SA(0, 1), a2 + hstep, voffA);
            PG8_WAIT_V(8); PG8_WAIT_L(0); PG8_BAR; PG8_MMA(0, 0, At, B0); PG8_MMA(0, 1, At, B1); PG8_BAR; PG8_SCHED;
            PG8_LDA(At, 1, 1); PG8_STAGE(PG8_SB(1, 0), b3, voffB); PG8_STAGE(PG8_SB(1, 1), b3 + hstep, voffB); PG8_STAGE(PG8_SA(1, 0), a3, voffA);
            PG8_WAIT_V(8); PG8_WAIT_L(0); PG8_BAR; PG8_MMA(1, 0, At, B0); PG8_MMA(1, 1, At, B1); PG8_BAR; PG8_SCHED;
        }
        if (wr == 0) PG8_BAR;
        { const int l2 = lane_id_v(); E(acc, cur, wr, wc, l2 & 15, l2 >> 4, stn, ui); if (has_next) stn.load(E.stats, nxt.pm * 256 + wr * 64, l2); }
        if (!has_next) break;
#pragma unroll
        for (int a = 0; a < 2; ++a)
#pragma unroll
            for (int b = 0; b < 2; ++b)
#pragma unroll
                for (int m = 0; m < 4; ++m)
#pragma unroll
                    for (int n = 0; n < 2; ++n) acc[a][b][m][n] = (f32x4){0.f, 0.f, 0.f, 0.f};
        cur = nxt; cA = nA; cB = nB; ++ui;
        if (wr == 1) PG8_BAR;
    }
    PG8_WAIT_V(0);
    PG8_BAR;
#undef PG8_SA
#undef PG8_SB
#undef PG8_STAGE
#undef PG8_LDA
#undef PG8_LDB
#undef PG8_MMA
#undef PG8_WAIT_V
#undef PG8_WAIT_L
#undef PG8_BAR
#undef PG8_SCHED
}
}


struct EpiUp {
    static constexpr bool PERM = true;
    const float* stats; const cfix_t* c1; const cfix_t* c2; unsigned char* ws; const LAS float* ctab;
    __device__ __forceinline__ void operator()(const f32x4 (&acc)[2][2][4][2], const pg8::Unit& u, int wr, int wc, int fr, int fq, const UnitStats& st, int ui) const {
        asm volatile("" : "+v"(fr), "+v"(fq));
        const int lane = fr + 16 * fq, rowbase = u.pm * 256 + wr * 64;
        const int n0 = u.pn * 256 + wc * 32 + 8 * fq, gcol = u.pn * 128 + wc * 32 + 8 * fq;
        bf16_t* G = (bf16_t*)(ws + OFF_G);
        f32x4 ka1[2], ka2[2], ku1[2], ku2[2];
#pragma unroll
        for (int n = 0; n < 2; ++n) { const LAS float* ct = ctab + ui * 512 + wc * 32 + 8 * fq + 4 * n; ka1[n] = *(const LAS f32x4*)ct; ka2[n] = *(const LAS f32x4*)(ct + 256); ku1[n] = *(const LAS f32x4*)(ct + 128); ku2[n] = *(const LAS f32x4*)(ct + 384); }
#pragma unroll
        for (int ai = 0; ai < 2; ++ai)
#pragma unroll
            for (int m = 0; m < 4; ++m) {
                float mu, rs; st.get(ai, m, fr, mu, rs);
                const int r = rowbase + 128 * ai + 16 * m + fr;
                float o[8];
#pragma unroll
                for (int n = 0; n < 2; ++n) {
#pragma unroll
                    for (int j = 0; j < 4; ++j) {
                        const float av = rs * (acc[ai][0][m][n][j] - mu * ka1[n][j]) + ka2[n][j];
                        const float uu = rs * (acc[ai][1][m][n][j] - mu * ku1[n][j]) + ku2[n][j];
                        o[4 * n + j] = silu_f(av) * uu;
                    }
                }
                u32x4 w; w.x = cvt_pk_bf16(o[0], o[1]); w.y = cvt_pk_bf16(o[2], o[3]); w.z = cvt_pk_bf16(o[4], o[5]); w.w = cvt_pk_bf16(o[6], o[7]);
                __builtin_nontemporal_store(w, (u32x4*)(G + (size_t)r * GW + gcol));
            }
    }
    __device__ __forceinline__ void tail(int u, int row, int c, float p0, float p1, float q0, float q1) const {
        const int r = TM + row, n0 = (u >> 2) * 256 + (u & 3) * 32 + c, gcol = (u >> 2) * 128 + (u & 3) * 32 + c;
        float mu, rs; load_row_stat(stats, r, mu, rs);
        const float a0 = rs * (p0 - mu * cfix2f(c1[n0])) + cfix2f(c2[n0]), a1 = rs * (p1 - mu * cfix2f(c1[n0 + 1])) + cfix2f(c2[n0 + 1]);
        const float u0 = rs * (q0 - mu * cfix2f(c1[n0 + 128])) + cfix2f(c2[n0 + 128]), u1 = rs * (q1 - mu * cfix2f(c1[n0 + 129])) + cfix2f(c2[n0 + 129]);
        *(unsigned*)((bf16_t*)(ws + OFF_G) + (size_t)r * GW + gcol) = cvt_pk_bf16(silu_f(a0) * u0, silu_f(a1) * u1);
    }
};

struct EpiRes {
    static constexpr bool PERM = false;
    const float* stats; float* stats_new; const float* lg; const float* lb; float* zf; unsigned char* ws; float bscale;
    int fin; const float* fg; const float* fb; unsigned* cnt; const LAS float* ctab;
    __device__ __forceinline__ void operator()(f32x4 (&acc)[2][2][4][2], const pg8::Unit& u, int wr, int wc, int fr, int fq, const UnitStats& st, int ui) const {
        asm volatile("" : "+v"(fr), "+v"(fq));
        const int lane = fr + 16 * fq, rowbase = u.pm * 256 + wr * 64;
        const int col0 = u.pn * 256 + wc * 32 + 4 * fq;
        bf16_t* zb = (bf16_t*)(ws + OFF_ZB);
        f32x4 gvh[2][2], bvh[2][2];
#pragma unroll
        for (int bj = 0; bj < 2; ++bj)
#pragma unroll
            for (int n = 0; n < 2; ++n) { const LAS float* ct = ctab + wc * 32 + 4 * fq + 128 * bj + 16 * n; gvh[bj][n] = *(const LAS f32x4*)ct; bvh[bj][n] = *(const LAS f32x4*)(ct + 256); }
        u32x2 zp[2][2];
        { const bf16_t* z0 = zb + (size_t)(rowbase + fr) * 1024 + col0;
#pragma unroll
          for (int bj = 0; bj < 2; ++bj)
#pragma unroll
            for (int n = 0; n < 2; ++n) zp[bj][n] = *(const u32x2*)(z0 + 128 * bj + 16 * n); }
#pragma unroll
        for (int ai = 0; ai < 2; ++ai)
#pragma unroll
            for (int m = 0; m < 4; ++m) {
                float mu, rs; st.get(ai, m, fr, mu, rs);
                const int r = rowbase + 128 * ai + 16 * m + fr;
                bf16_t* br = zb + (size_t)r * 1024 + col0;
                f32x4 zc[2][2];
#pragma unroll
                for (int bj = 0; bj < 2; ++bj)
#pragma unroll
                    for (int n = 0; n < 2; ++n) { const u32x2 q = zp[bj][n]; zc[bj][n] = (f32x4){bf2f(q.x & 0xffffu), bf2f(q.x >> 16), bf2f(q.y & 0xffffu), bf2f(q.y >> 16)}; }
                if (ai * 4 + m < 7) {
                    const int rn = rowbase + 128 * ((ai * 4 + m + 1) >> 2) + 16 * ((ai * 4 + m + 1) & 3) + fr;
                    const bf16_t* zn_ = zb + (size_t)rn * 1024 + col0;
#pragma unroll
                    for (int bj = 0; bj < 2; ++bj)
#pragma unroll
                        for (int n = 0; n < 2; ++n) zp[bj][n] = *(const u32x2*)(zn_ + 128 * bj + 16 * n);
                }
                float s = 0.f, ss = 0.f;
#pragma unroll
                for (int bj = 0; bj < 2; ++bj)
#pragma unroll
                    for (int n = 0; n < 2; ++n) {
                        f32x4 zn;
                        const f32x4 gv = gvh[bj][n], bv = bvh[bj][n];
#pragma unroll
                        for (int j = 0; j < 4; ++j) { const float h = (zc[bj][n][j] - mu) * rs * gv[j] + bv[j]; zn[j] = ALPHA * h + bscale * acc[ai][bj][m][n][j]; s += zn[j]; ss += zn[j] * zn[j]; }
                        acc[ai][bj][m][n] = zn;
                        if (!fin) {
                            u32x2 w; w.x = cvt_pk_bf16(zn[0], zn[1]); w.y = cvt_pk_bf16(zn[2], zn[3]);
                            *(u32x2*)(br + 128 * bj + 16 * n) = w;
                        }
                    }
                s += shfl_x(s, lane, 16); s += shfl_x(s, lane, 32); ss += shfl_x(ss, lane, 16); ss += shfl_x(ss, lane, 32);
                if (fq == 0) *(f32x2*)(stats_new + (size_t)r * 32 + (u.pn * 4 + wc) * 2) = (f32x2){s, ss};
            }
        if (fin) {
            asm volatile("s_waitcnt vmcnt(0)" ::: "memory");
            __builtin_amdgcn_s_barrier();
            if (wr == 0 && wc == 0 && lane == 0) {
                __builtin_amdgcn_fence(__ATOMIC_RELEASE, "agent");
                asm volatile("s_waitcnt vmcnt(0)" ::: "memory");
                __hip_atomic_fetch_add(cnt + 4 * u.pm, 1u, __ATOMIC_RELAXED, __HIP_MEMORY_SCOPE_AGENT);
                unsigned sp = 0;
                while (__hip_atomic_load(cnt + 4 * u.pm, __ATOMIC_RELAXED, __HIP_MEMORY_SCOPE_AGENT) < 4u) { __builtin_amdgcn_s_sleep(1); if (++sp > (1u << 22)) break; }
                __builtin_amdgcn_fence(__ATOMIC_ACQUIRE, "agent");
                asm volatile("s_waitcnt vmcnt(0)" ::: "memory");
            }
            __builtin_amdgcn_s_barrier();
            asm volatile("" : "+v"(fr), "+v"(fq) :: "memory");
            const int lane2 = fr + 16 * fq, colf = u.pn * 256 + wc * 32 + 4 * fq;
            UnitStats sf; sf.load(stats_new, rowbase, lane2);
            f32x4 fgv[2][2], fbv[2][2];
#pragma unroll
            for (int bj = 0; bj < 2; ++bj)
#pragma unroll
                for (int n = 0; n < 2; ++n) { const LAS float* ct = ctab + 512 + wc * 32 + 4 * fq + 128 * bj + 16 * n; fgv[bj][n] = *(const LAS f32x4*)ct; fbv[bj][n] = *(const LAS f32x4*)(ct + 256); }
#pragma unroll
            for (int ai = 0; ai < 2; ++ai)
#pragma unroll
                for (int m = 0; m < 4; ++m) {
                    float mu, rs; sf.get(ai, m, fr, mu, rs);
                    const int r = rowbase + 128 * ai + 16 * m + fr;
                    float* orow = zf + (size_t)r * 1024 + colf;
#pragma unroll
                    for (int bj = 0; bj < 2; ++bj)
#pragma unroll
                        for (int n = 0; n < 2; ++n) {
                            const f32x4 gv = fgv[bj][n], bv = fbv[bj][n];
                            f32x4 o;
#pragma unroll
                            for (int j = 0; j < 4; ++j) o[j] = (acc[ai][bj][m][n][j] - mu) * rs * gv[j] + bv[j];
                            *(f32x4*)(orow + 128 * bj + 16 * n) = o;
                        }
                    asm volatile("" ::: "memory");
                }
        }
    }
    __device__ __forceinline__ void tail(int u, int row, int c, float p0, float p1, float q0, float q1) const {
        const int r = TM + row, n0 = (u >> 2) * 256 + (u & 3) * 32 + c;
        float mu, rs; load_row_stat(stats, r, mu, rs);
        bf16_t* br = (bf16_t*)(ws + OFF_ZB) + (size_t)r * 1024;
        const float acc4[4] = {p0, p1, q0, q1}; const int cols[4] = {n0, n0 + 1, n0 + 128, n0 + 129};
        float zn[4]; float s = 0.f, ss = 0.f;
#pragma unroll
        for (int k = 0; k < 4; ++k) { const float h = (bf2f(br[cols[k]]) - mu) * rs * lg[cols[k]] + lb[cols[k]]; zn[k] = ALPHA * h + bscale * acc4[k]; s += zn[k]; ss += zn[k] * zn[k]; }
        *(unsigned*)(br + n0) = cvt_pk_bf16(zn[0], zn[1]); *(unsigned*)(br + n0 + 128) = cvt_pk_bf16(zn[2], zn[3]);
        { const int ln = lane_id_v();
#pragma unroll
        for (int o = 1; o < 16; o <<= 1) { s += shfl_x(s, ln, o); ss += shfl_x(ss, ln, o); } }
        if ((c & 30) == 0) *(f32x2*)(stats_new + (size_t)r * 32 + u * 2) = (f32x2){s, ss};
    }
};

struct EpiIn {
    static constexpr bool PERM = true;
    const float* stats; const cfix_t* c1; const cfix_t* c2; unsigned char* ws; const LAS float* ctab;
    __device__ __forceinline__ void operator()(const f32x4 (&acc)[2][2][4][2], const pg8::Unit& u, int wr, int wc, int fr, int fq, const UnitStats& st, int ui) const {
        asm volatile("" : "+v"(fr), "+v"(fq));
        const int lane = fr + 16 * fq, rowbase = u.pm * 256 + wr * 64;
        const int n0 = u.pn * 256 + wc * 32 + 8 * fq, pn = u.pn;
        f32x4 k1[2][2], k2[2][2];
#pragma unroll
        for (int bj = 0; bj < 2; ++bj)
#pragma unroll
            for (int n = 0; n < 2; ++n) { const LAS float* ct = ctab + ui * 512 + 128 * bj + wc * 32 + 8 * fq + 4 * n; k1[bj][n] = *(const LAS f32x4*)ct; k2[bj][n] = *(const LAS f32x4*)(ct + 256); }
#define VAL(ai, bj, m, n, j) (rs * (acc[ai][bj][m][n][j] - mu * k1[bj][n][j]) + k2[bj][n][j])
        if (pn == 0 || pn >= 7) {
            bf16_t* dst; int ld, col; const bool act = pn >= 9;
            if (pn == 0) { dst = (bf16_t*)(ws + OFF_XP); ld = 256; col = wc * 32 + 8 * fq; } else if (pn <= 8) { dst = (bf16_t*)(ws + OFF_V); ld = 512; col = 256 * (pn - 7) + wc * 32 + 8 * fq; } else { dst = (bf16_t*)(ws + OFF_SG); ld = 512; col = 256 * (pn - 9) + wc * 32 + 8 * fq; }
#pragma unroll
            for (int ai = 0; ai < 2; ++ai)
#pragma unroll
                for (int m = 0; m < 4; ++m) {
                    float mu, rs; st.get(ai, m, fr, mu, rs);
                    const int r = rowbase + 128 * ai + 16 * m + fr;
#pragma unroll
                    for (int bj = 0; bj < 2; ++bj) {
                        float o[8];
#pragma unroll
                        for (int n = 0; n < 2; ++n)
#pragma unroll
                            for (int j = 0; j < 4; ++j) { const float v = VAL(ai, bj, m, n, j); o[4 * n + j] = act ? silu_f(v) : v; }
                        u32x4 w; w.x = cvt_pk_bf16(o[0], o[1]); w.y = cvt_pk_bf16(o[2], o[3]); w.z = cvt_pk_bf16(o[4], o[5]); w.w = cvt_pk_bf16(o[6], o[7]);
                        *(u32x4*)(dst + (size_t)r * ld + col + 128 * bj) = w;
                    }
                }
        } else if (pn <= 2) {
            const int col = 128 * (pn - 1) + wc * 32 + 8 * fq;
            bf16_t* U = (bf16_t*)(ws + OFF_U);
#pragma unroll
            for (int ai = 0; ai < 2; ++ai)
#pragma unroll
                for (int m = 0; m < 4; ++m) {
                    float mu, rs; st.get(ai, m, fr, mu, rs);
                    const int r = rowbase + 128 * ai + 16 * m + fr;
                    float o[8];
#pragma unroll
                    for (int n = 0; n < 2; ++n)
#pragma unroll
                        for (int j = 0; j < 4; ++j) o[4 * n + j] = VAL(ai, 0, m, n, j) * fast_sigmoid(VAL(ai, 1, m, n, j));
                    u32x4 w; w.x = cvt_pk_bf16(o[0], o[1]); w.y = cvt_pk_bf16(o[2], o[3]); w.z = cvt_pk_bf16(o[4], o[5]); w.w = cvt_pk_bf16(o[6], o[7]);
                    *(u32x4*)(U + (size_t)r * 256 + col) = w;
                }
        } else {
            const bool isk = pn >= 5;
            const int head = 2 * ((pn - 3) & 1) + (wc >> 1), d0 = 32 * (wc & 1) + 8 * fq;
            bf16_t* dst = (bf16_t*)(ws + (isk ? OFF_K : OFF_Q)); bf16_t* K2 = (bf16_t*)(ws + OFF_K2);
            const float* rope = (const float*)(ws + OFF_ROPE);
            const float scale = isk ? 0.08838834764831845f : 1.0f;
            const float lgam = log2_gamma(head);
            f32x4 csn[4];
            { const f32x4* cs0 = (const f32x4*)(rope + ((size_t)(((rowbase + fr) & 8191) + NMETA) * 64 + d0) * 2);
#pragma unroll
              for (int q = 0; q < 4; ++q) csn[q] = cs0[q]; }
#pragma unroll
            for (int ai = 0; ai < 2; ++ai)
#pragma unroll
                for (int m = 0; m < 4; ++m) {
                    float mu, rs; st.get(ai, m, fr, mu, rs);
                    const int r = rowbase + 128 * ai + 16 * m + fr;
                    const int ci = r & 63;
                    f32x4 cs[4];
#pragma unroll
                    for (int q = 0; q < 4; ++q) cs[q] = csn[q];
                    if (ai * 4 + m < 7) {
                        const int rn = rowbase + 128 * ((ai * 4 + m + 1) >> 2) + 16 * ((ai * 4 + m + 1) & 3) + fr;
                        const f32x4* csp = (const f32x4*)(rope + ((size_t)((rn & 8191) + NMETA) * 64 + d0) * 2);
#pragma unroll
                        for (int q = 0; q < 4; ++q) csn[q] = csp[q];
                    }
                    const size_t off = (size_t)r * 512 + head * 128 + d0;
                    float o1[8], o2[8];
#pragma unroll
                    for (int n = 0; n < 2; ++n) {
                        const f32x4 csA = cs[2 * n], csB = cs[2 * n + 1];
                        const float cc[4] = {csA.x, csA.z, csB.x, csB.z}, sn[4] = {csA.y, csA.w, csB.y, csB.w};
#pragma unroll
                        for (int j = 0; j < 4; ++j) { const float x1 = VAL(ai, 0, m, n, j), x2 = VAL(ai, 1, m, n, j);
                            o1[4 * n + j] = (x1 * cc[j] - x2 * sn[j]) * scale; o2[4 * n + j] = (x2 * cc[j] + x1 * sn[j]) * scale; }
                    }
                    {
                        u32x4 w1, w2; w1.x = cvt_pk_bf16(o1[0], o1[1]); w1.y = cvt_pk_bf16(o1[2], o1[3]); w1.z = cvt_pk_bf16(o1[4], o1[5]); w1.w = cvt_pk_bf16(o1[6], o1[7]);
                        w2.x = cvt_pk_bf16(o2[0], o2[1]); w2.y = cvt_pk_bf16(o2[2], o2[3]); w2.z = cvt_pk_bf16(o2[4], o2[5]); w2.w = cvt_pk_bf16(o2[6], o2[7]);
                        *(u32x4*)(dst + off) = w1; *(u32x4*)(dst + off + 64) = w2;
                    }
                }
        }
#undef VAL
    }
    __device__ __forceinline__ void tail(int u, int row, int c, float p0, float p1, float q0, float q1) const {
        bf16_t *XP = (bf16_t*)(ws + OFF_XP), *U = (bf16_t*)(ws + OFF_U), *Q = (bf16_t*)(ws + OFF_Q), *K = (bf16_t*)(ws + OFF_K), *K2 = (bf16_t*)(ws + OFF_K2), *V = (bf16_t*)(ws + OFF_V), *SG = (bf16_t*)(ws + OFF_SG);
        const float* rope = (const float*)(ws + OFF_ROPE);
        const int r = TM + row, pn = u >> 2, wc = u & 3, n0 = pn * 256 + wc * 32 + c;
        float mu, rs; load_row_stat(stats, r, mu, rs);
        const float a0 = rs * (p0 - mu * cfix2f(c1[n0])) + cfix2f(c2[n0]), a1 = rs * (p1 - mu * cfix2f(c1[n0 + 1])) + cfix2f(c2[n0 + 1]);
        const float b0 = rs * (q0 - mu * cfix2f(c1[n0 + 128])) + cfix2f(c2[n0 + 128]), b1 = rs * (q1 - mu * cfix2f(c1[n0 + 129])) + cfix2f(c2[n0 + 129]);
        if (pn == 0 || pn >= 7) {
            bf16_t* dst; int ld, col; const bool act = pn >= 9;
            if (pn == 0) { dst = XP; ld = 256; col = wc * 32 + c; } else if (pn <= 8) { dst = V; ld = 512; col = 256 * (pn - 7) + wc * 32 + c; } else { dst = SG; ld = 512; col = 256 * (pn - 9) + wc * 32 + c; }
            *(unsigned*)(dst + (size_t)r * ld + col) = act ? cvt_pk_bf16(silu_f(a0), silu_f(a1)) : cvt_pk_bf16(a0, a1);
            *(unsigned*)(dst + (size_t)r * ld + col + 128) = act ? cvt_pk_bf16(silu_f(b0), silu_f(b1)) : cvt_pk_bf16(b0, b1);
        } else if (pn <= 2) {
            *(unsigned*)(U + (size_t)r * 256 + 128 * (pn - 1) + wc * 32 + c) = cvt_pk_bf16(a0 * fast_sigmoid(b0), a1 * fast_sigmoid(b1));
        } else {
            const bool isk = pn >= 5;
            const int head = 2 * ((pn - 3) & 1) + (wc >> 1), d = 32 * (wc & 1) + c, t = row & 15, ci = 48 + t;
            const float scale = isk ? 0.08838834764831845f : 1.0f;
            const f32x4 cs = *(const f32x4*)(rope + ((size_t)t * 64 + d) * 2);
            const float o10 = (a0 * cs.x - b0 * cs.y) * scale, o20 = (b0 * cs.x + a0 * cs.y) * scale;
            const float o11 = (a1 * cs.z - b1 * cs.w) * scale, o21 = (b1 * cs.z + a1 * cs.w) * scale;
            bf16_t* dst = isk ? K : Q; const size_t off = (size_t)r * 512 + head * 128 + d;
            *(unsigned*)(dst + off) = cvt_pk_bf16(o10, o11); *(unsigned*)(dst + off + 64) = cvt_pk_bf16(o20, o21);
        }
    }
};

template <class Epi>
__device__ __forceinline__ void tail_units(unsigned char* smem, const bf16_t* At, const bf16_t* Bt, int K, int nunits, int c0, const Epi& E, const int tid, const int bid) {
    const int wid = tid >> 6, lane = tid & 63; constexpr int G = GRID;
    float* part = (float*)smem;
    const int kw = K / 8;
    for (int u = (bid - c0 + G) % G; u < nunits; u += G) {
        const int n0 = (u >> 2) * 256 + (u & 3) * 32;
        f32x16 acc0, acc1;
#pragma unroll
        for (int i = 0; i < 16; ++i) { acc0[i] = 0.f; acc1[i] = 0.f; }
        const bf16_t* ap = At + (size_t)(lane & 31) * K + wid * kw + 8 * (lane >> 5);
        const bf16_t* bp0 = Bt + (size_t)(n0 + (lane & 31)) * K + wid * kw + 8 * (lane >> 5);
        const bf16_t* bp1 = bp0 + (size_t)128 * K;
        for (int k0 = 0; k0 < kw; k0 += 64) {
            bf16x8 av[4], b0v[4], b1v[4];
#pragma unroll
            for (int j = 0; j < 4; ++j) if (k0 + 16 * j < kw) { av[j] = *(const bf16x8*)(ap + k0 + 16 * j); b0v[j] = *(const bf16x8*)(bp0 + k0 + 16 * j); b1v[j] = *(const bf16x8*)(bp1 + k0 + 16 * j); }
#pragma unroll
            for (int j = 0; j < 4; ++j) if (k0 + 16 * j < kw) {
                acc0 = __builtin_amdgcn_mfma_f32_32x32x16_bf16(av[j], b0v[j], acc0, 0, 0, 0);
                acc1 = __builtin_amdgcn_mfma_f32_32x32x16_bf16(av[j], b1v[j], acc1, 0, 0, 0);
            }
        }
#pragma unroll
        for (int i = 0; i < 16; ++i) { const int row = (i & 3) + 8 * (i >> 2) + 4 * (lane >> 5); part[wid * 2048 + row * 64 + (lane & 31)] = acc0[i]; part[wid * 2048 + row * 64 + 32 + (lane & 31)] = acc1[i]; }
        __syncthreads();
        const int row = tid >> 4, c = (tid & 15) * 2;
        float p0 = 0.f, p1 = 0.f, q0 = 0.f, q1 = 0.f;
#pragma unroll
        for (int w = 0; w < 8; ++w) { const float* pp = part + w * 2048 + row * 64 + c; p0 += pp[0]; p1 += pp[1]; q0 += pp[32]; q1 += pp[33]; }
        E.tail(u, row, c, p0, p1, q0, q1);
        __syncthreads();
    }
}


__device__ __forceinline__ bf16x8 tr_frag(const unsigned char* tile, int stride, int row0, int col0, int lane) {
    const int g = lane >> 4, q = (lane & 15) >> 2, p = lane & 3;
    const unsigned char* a0 = tile + (row0 + 4 * g + q) * stride + (col0 + 4 * p) * 2;
    const v4i16_t lo = __builtin_amdgcn_ds_read_tr16_b64_v4i16((LAS v4i16_t*)(a0));
    const v4i16_t hi = __builtin_amdgcn_ds_read_tr16_b64_v4i16((LAS v4i16_t*)(a0 + 16 * stride));
    bf16x8 r; r[0] = lo[0]; r[1] = lo[1]; r[2] = lo[2]; r[3] = lo[3]; r[4] = hi[0]; r[5] = hi[1]; r[6] = hi[2]; r[7] = hi[3];
    return r;
}
template <int NKS>
__device__ __forceinline__ void tile_gemm_loadB(bf16x8 (&bf)[NKS][2], const bf16_t* Bt, int ks_lo, int wave, int lane) {
    const bf16_t* bp = Bt + (size_t)(32 * wave + (lane & 15)) * 256 + 8 * (lane >> 4) + 32 * ks_lo;
#pragma unroll
    for (int ks = 0; ks < NKS; ++ks) { bf[ks][0] = *(const bf16x8*)(bp + 32 * ks); bf[ks][1] = *(const bf16x8*)(bp + 16 * 256 + 32 * ks); }
}
template <int NKS>
__device__ __forceinline__ void tile_gemm64(const unsigned char* At, int ast, const bf16x8 (&bf)[NKS][2], int ks_lo, int lane, f32x4 (&acc)[4][2]) {
#pragma unroll
    for (int mt = 0; mt < 4; ++mt) { acc[mt][0] = (f32x4){0.f, 0.f, 0.f, 0.f}; acc[mt][1] = (f32x4){0.f, 0.f, 0.f, 0.f}; }
    const unsigned char* ap = At + (lane & 15) * ast + 16 * (lane >> 4) + 64 * ks_lo;
#pragma unroll
    for (int ks = 0; ks < NKS; ++ks) {
#pragma unroll
        for (int mt = 0; mt < 4; ++mt) {
            const bf16x8 av = *(const bf16x8*)(ap + 16 * mt * ast + 64 * ks);
            acc[mt][0] = __builtin_amdgcn_mfma_f32_16x16x32_bf16(bf[ks][0], av, acc[mt][0], 0, 0, 0);
            acc[mt][1] = __builtin_amdgcn_mfma_f32_16x16x32_bf16(bf[ks][1], av, acc[mt][1], 0, 0, 0);
        }
    }
}
__device__ __forceinline__ void load_tok_tile(unsigned char* tile, const bf16_t* src, int b, int t0, int halo, int tid) {
    const int nchunk = (64 + halo) * 32;
    u32x4 v[6];
#pragma unroll
    for (int k = 0; k < 6; ++k) {
        const int idx = tid + 512 * k, row = idx >> 5, ch = idx & 31, t = t0 - halo + row;
        const bool ok = idx < nchunk && t >= 0 && t < LSEQ;
        const u32x4 ld = *(const u32x4*)(src + (size_t)tok_row(b, ok ? t : 0) * 256 + ch * 8);
        v[k] = ok ? ld : (u32x4){0u, 0u, 0u, 0u};
    }
#pragma unroll
    for (int k = 0; k < 6; ++k) { const int idx = tid + 512 * k, row = idx >> 5, ch = idx & 31; if (idx < nchunk) *(u32x4*)(tile + row * 512 + ch * 16) = v[k]; }
}
constexpr int ATS = 528;
constexpr int YS = 260;
constexpr int KTS = 272;
constexpr int LDS_AT = 49152, LDS_Y = 49152;

__device__ __forceinline__ void store_tile64(const f32x4 (&acc)[4][2], unsigned char* stage, bf16_t* YC, int colbase, int b, int t0, int tid) {
    const int lane = tid & 63, wave = tid >> 6;
#pragma unroll
    for (int mt = 0; mt < 4; ++mt)
#pragma unroll
        for (int nt = 0; nt < 2; ++nt) { u32x2 w; w.x = cvt_pk_bf16(acc[mt][nt][0], acc[mt][nt][1]); w.y = cvt_pk_bf16(acc[mt][nt][2], acc[mt][nt][3]);
            *(u32x2*)(stage + (16 * mt + (lane & 15)) * ATS + (32 * wave + 16 * nt + 4 * (lane >> 4)) * 2) = w; }
    __syncthreads();
#pragma unroll
    for (int k = 0; k < 4; ++k) {
        const int idx = tid + 512 * k, tok = idx >> 5, ch = idx & 31, t = t0 + tok;
        const u32x4 v = *(const u32x4*)(stage + tok * ATS + ch * 16);
        if (t < LSEQ) *(u32x4*)(YC + (size_t)tok_row(b, t) * 1024 + colbase + ch * 8) = v;
    }
}

__device__ __forceinline__ void pool_item(unsigned char* smem, const bf16_t* XP, const bf16_t* PPT, bf16_t* YC, int b, int tb, int tid) {
    const int t0 = 64 * tb, lane = tid & 63, wave = tid >> 6;
    load_tok_tile(smem, XP, b, t0, 15, tid);
    bf16x8 bfr[2][2]; tile_gemm_loadB<2>(bfr, PPT, 2 * (wave >> 1), wave, lane);
    __syncthreads();
    {
        const int c = tid & 255, i0 = (tid >> 8) * 32, gi = c >> 6, w = 2 << gi;
        const bf16_t* xt = (const bf16_t*)smem;
        float s = 0.f;
#pragma unroll 1
        for (int k = 1; k < w; ++k) s += bf2f(xt[(i0 + 15 - k) * 256 + c]);
        bf16_t* at = (bf16_t*)(smem + LDS_AT);
#pragma unroll 1
        for (int ib = i0; ib < i0 + 32; ib += 8) {
            unsigned short xa[8], xo[8];
#pragma unroll
            for (int q = 0; q < 8; ++q) { xa[q] = xt[(ib + q + 15) * 256 + c]; xo[q] = xt[(ib + q + 15 - (w - 1)) * 256 + c]; }
#pragma unroll
            for (int q = 0; q < 8; ++q) {
                const float xv = bf2f(xa[q]);
                s += xv;
                const int t = t0 + ib + q, cnt = (t + 1 < w) ? (t + 1) : w;
                at[(ib + q) * (ATS / 2) + c] = (bf16_t)f2bf(s * __builtin_amdgcn_rcpf((float)cnt) - xv);
                s -= bf2f(xo[q]);
            }
        }
    }
    __syncthreads();
    f32x4 acc[4][2];
    tile_gemm64<2>(smem + LDS_AT, ATS, bfr, 2 * (wave >> 1), lane, acc);
    store_tile64(acc, smem, YC, 0, b, t0, tid);
    __syncthreads();
}

__device__ __forceinline__ void conv_item(unsigned char* smem, const bf16_t* U, const bf16_t* PWT, const float* dw, const float* db, const float* lng, const float* lnb, bf16_t* YC, int b, int tb, int tid) {
    const int t0 = 64 * tb, lane = tid & 63, wave = tid >> 6;
    float w[31];
    {
        const int c = tid & 255;
#pragma unroll
        for (int j = 0; j < 31; ++j) w[j] = dw[j * 256 + c];
    }
    const float bias = db[tid & 255];
    load_tok_tile(smem, U, b, t0, 30, tid);
    __syncthreads();
    {
        const int c = tid & 255, i0 = (tid >> 8) * 32;
        const bf16_t* ut = (const bf16_t*)smem;
        float* Y = (float*)(smem + LDS_Y);
#pragma unroll 1
        for (int grp = 0; grp < 4; ++grp) {
            float a8[8];
#pragma unroll
            for (int i = 0; i < 8; ++i) a8[i] = bias;
            const bf16_t* up = ut + (i0 + grp * 8) * 256 + c;
#pragma unroll
            for (int jb = 0; jb < 40; jb += 8) {
                unsigned short raw[8];
#pragma unroll
                for (int q = 0; q < 8; ++q) raw[q] = (jb + q < 38) ? up[(jb + q) * 256] : (unsigned short)0;
#pragma unroll
                for (int q = 0; q < 8; ++q) {
                    const int jj = jb + q; const float v = bf2f(raw[q]);
#pragma unroll
                    for (int i = 0; i < 8; ++i) if (jj < 38 && jj - i >= 0 && jj - i <= 30) a8[i] += w[jj - i] * v;
                }
            }
#pragma unroll
            for (int i = 0; i < 8; ++i) Y[(i0 + grp * 8 + i) * YS + c] = a8[i];
        }
    }
    __syncthreads();
    bf16x8 bfr[8][2]; tile_gemm_loadB<8>(bfr, PWT, 0, wave, lane);
    {
        const float* Y = (const float*)(smem + LDS_Y);
        const f32x4 gg = *(const f32x4*)(lng + 4 * lane), bb = *(const f32x4*)(lnb + 4 * lane);
#pragma unroll 2
        for (int k = 0; k < 8; ++k) {
            const int tok = 8 * wave + k;
            f32x4 y = *(const f32x4*)(Y + tok * YS + 4 * lane);
            float s1 = (y.x + y.y) + (y.z + y.w), s2 = (y.x * y.x + y.y * y.y) + (y.z * y.z + y.w * y.w);
#pragma unroll
            for (int o = 1; o < 64; o <<= 1) { s1 += shfl_x(s1, lane, o); s2 += shfl_x(s2, lane, o); }
            const float mean = s1 * (1.f / 256.f);
            const float rstd = rsqrtf(fmaxf(s2 * (1.f / 256.f) - mean * mean, 0.f) + LN_EPS);
            y = y - mean;
            const f32x4 n = y * rstd * gg + bb;
            u32x2 pk; pk.x = cvt_pk_bf16(silu_f(n.x), silu_f(n.y)); pk.y = cvt_pk_bf16(silu_f(n.z), silu_f(n.w));
            *(u32x2*)(smem + tok * ATS + 8 * lane) = pk;
        }
    }
    __syncthreads();
    f32x4 acc[4][2];
    tile_gemm64<8>(smem, ATS, bfr, 0, lane, acc);
    store_tile64(acc, smem + LDS_Y, YC, 256, b, t0, tid);
    __syncthreads();
}

__device__ __forceinline__ int chunk_row(int b, int n, int p) { return n == 0 ? (p >= 48 ? TM + 16 * b + p - 48 : -1) : SEQ * b + 64 * (n - 1) + p; }
__device__ __forceinline__ void chunk_tile_load(u32x4 (&v)[2], const bf16_t* src, int b, int n, int h, int tid) {
#pragma unroll
    for (int k = 0; k < 2; ++k) {
        const int idx = tid + 512 * k, p = idx >> 4, ch = idx & 15, row = chunk_row(b, n, p);
        const u32x4 ld = *(const u32x4*)(src + (size_t)(row >= 0 ? row : 0) * 512 + h * 128 + ch * 8);
        v[k] = row >= 0 ? ld : (u32x4){0u, 0u, 0u, 0u};
    }
}
__device__ __forceinline__ void chunk_tile_store(unsigned char* tile, const u32x4 (&v)[2], int tid) {
#pragma unroll
    for (int k = 0; k < 2; ++k) { const int idx = tid + 512 * k, p = idx >> 4, ch = idx & 15; *(u32x4*)(tile + p * KTS + ch * 16) = v[k]; }
}
template <int NP>
__device__ __forceinline__ void kv_item(unsigned char* smem, const bf16_t* K2, const bf16_t* V, bf16_t* ST, int bh, int n, int tid) {
    const int lane = tid & 63, wave = tid >> 6, b = bh >> 2, h = bh & 3;
    {
        u32x4 vk[NP][2], vv[NP][2];
#pragma unroll
        for (int c = 0; c < NP; ++c) { chunk_tile_load(vk[c], K2, b, n + c, h, tid); chunk_tile_load(vv[c], V, b, n + c, h, tid); }
        {
            const float lgam = log2_gamma(h);
#pragma unroll
            for (int c = 0; c < NP; ++c)
#pragma unroll
                for (int k2 = 0; k2 < 2; ++k2) {
                    const float dec = __builtin_amdgcn_exp2f(lgam * (float)(63 - ((tid + 512 * k2) >> 4)));
                    u32x4 q = vk[c][k2];
                    q.x = cvt_pk_bf16(bf2f(q.x & 0xffffu) * dec, bf2f(q.x >> 16) * dec); q.y = cvt_pk_bf16(bf2f(q.y & 0xffffu) * dec, bf2f(q.y >> 16) * dec);
                    q.z = cvt_pk_bf16(bf2f(q.z & 0xffffu) * dec, bf2f(q.z >> 16) * dec); q.w = cvt_pk_bf16(bf2f(q.w & 0xffffu) * dec, bf2f(q.w >> 16) * dec);
                    vk[c][k2] = q;
                }
        }
#pragma unroll
        for (int c = 0; c < NP; ++c) { chunk_tile_store(smem + c * 128 * KTS, vk[c], tid); chunk_tile_store(smem + c * 128 * KTS + 64 * KTS, vv[c], tid); }
    }
    __syncthreads();
    const int dt0 = 2 * (wave & 3), et0 = 4 * (wave >> 2);
#pragma unroll
    for (int c = 0; c < NP; ++c) {
        const unsigned char* kt = smem + c * 128 * KTS;
        f32x4 acc[2][4];
#pragma unroll
        for (int dt = 0; dt < 2; ++dt)
#pragma unroll
            for (int et = 0; et < 4; ++et) acc[dt][et] = (f32x4){0.f, 0.f, 0.f, 0.f};
#pragma unroll
        for (int ks = 0; ks < 2; ++ks) {
            bf16x8 af[2], bfr[4];
#pragma unroll
            for (int dt = 0; dt < 2; ++dt) af[dt] = tr_frag(kt, KTS, 32 * ks, 16 * (dt0 + dt), lane);
#pragma unroll
            for (int et = 0; et < 4; ++et) bfr[et] = tr_frag(kt + 64 * KTS, KTS, 32 * ks, 16 * (et0 + et), lane);
#pragma unroll
            for (int dt = 0; dt < 2; ++dt)
#pragma unroll
                for (int et = 0; et < 4; ++et) acc[dt][et] = __builtin_amdgcn_mfma_f32_16x16x32_bf16(af[dt], bfr[et], acc[dt][et], 0, 0, 0);
        }
        bf16_t* dst = ST + ((size_t)(bh * NCHUNK + n + c)) * 16384;
#pragma unroll
        for (int dt = 0; dt < 2; ++dt)
#pragma unroll
            for (int et = 0; et < 4; ++et) { u32x2 w; w.x = cvt_pk_bf16(acc[dt][et][0], acc[dt][et][1]); w.y = cvt_pk_bf16(acc[dt][et][2], acc[dt][et][3]);
                *(u32x2*)(dst + (16 * (et0 + et) + (lane & 15)) * 128 + 16 * (dt0 + dt) + 4 * (lane >> 4)) = w; }
    }
    __syncthreads();
}

struct RetRegs { u32x4 vk[2], vv[2], vs[4]; bf16x8 qf[4]; u32x4 sg[2]; };
__device__ __forceinline__ void ret_load(RetRegs& R, const bf16_t* Q, const bf16_t* Kb, const bf16_t* V, const bf16_t* ST, const bf16_t* SG, int bh, int n, int tid) {
    const int lane = tid & 63, wave = tid >> 6, b = bh >> 2, h = bh & 3, g = lane >> 4, li = lane & 15, it = wave & 3, eh = wave >> 2;
    chunk_tile_load(R.vk, Kb, b, n, h, tid); chunk_tile_load(R.vv, V, b, n, h, tid);
    const bf16_t* sp = ST + ((size_t)(bh * NCHUNK + n)) * 16384;
#pragma unroll
    for (int k = 0; k < 4; ++k) { const int idx = tid + 512 * k, e = idx >> 4, ch = idx & 15; R.vs[k] = *(const u32x4*)(sp + e * 128 + ch * 8); }
    const int qrow = chunk_row(b, n, 16 * it + li);
#pragma unroll
    for (int ks = 0; ks < 4; ++ks) { const bf16x8 ld = *(const bf16x8*)(Q + (size_t)(qrow >= 0 ? qrow : 0) * 512 + h * 128 + 32 * ks + 8 * g); R.qf[ks] = qrow >= 0 ? ld : (bf16x8){0, 0, 0, 0, 0, 0, 0, 0}; }
#pragma unroll
    for (int k = 0; k < 2; ++k) {
        const int idx = tid + 512 * k, p = idx >> 4, ch = idx & 15, row = chunk_row(b, n, p);
        const u32x4 ld = *(const u32x4*)(SG + (size_t)(row >= 0 ? row : 0) * 512 + h * 128 + ch * 8);
        R.sg[k] = row >= 0 ? ld : (u32x4){0u, 0u, 0u, 0u};
    }
}
__device__ __forceinline__ void ret_item(unsigned char* smem, RetRegs& R, const bf16_t* Q, const bf16_t* Kb, const bf16_t* V, const bf16_t* ST, const bf16_t* SG, const float* gng, bf16_t* YC, int bh, int n, bool has_next, int nbh, int nn, int tid) {
    const int lane = tid & 63, wave = tid >> 6, b = bh >> 2, h = bh & 3, g = lane >> 4, li = lane & 15;
    unsigned char* KT = smem; unsigned char* VT = smem + 64 * KTS; unsigned char* STt = smem + 128 * KTS; float* PS = (float*)(smem + 256 * KTS);
    const int it = wave & 3, eh = wave >> 2;
    chunk_tile_store(KT, R.vk, tid); chunk_tile_store(VT, R.vv, tid);
#pragma unroll
    for (int k = 0; k < 4; ++k) { const int idx = tid + 512 * k, e = idx >> 4, ch = idx & 15; *(u32x4*)(STt + e * KTS + ch * 16) = R.vs[k]; }
    bf16x8 qf[4]; u32x4 sgc[2];
#pragma unroll
    for (int ks = 0; ks < 4; ++ks) qf[ks] = R.qf[ks];
    sgc[0] = R.sg[0]; sgc[1] = R.sg[1];
    __syncthreads();
    if (has_next) ret_load(R, Q, Kb, V, ST, SG, nbh, nn, tid);
    const float lgam = log2_gamma(h);
    float ggv[4];
#pragma unroll
    for (int et = 0; et < 4; ++et) ggv[et] = gng[h * 128 + 64 * eh + 16 * et + li];
    bf16x8 pf[2];
#pragma unroll
    for (int jt = 0; jt < 4; ++jt) {
        f32x4 sacc = (f32x4){0.f, 0.f, 0.f, 0.f};
#pragma unroll
        for (int ks = 0; ks < 4; ++ks) { const bf16x8 kf = *(const bf16x8*)(KT + (16 * jt + li) * KTS + 64 * ks + 16 * g); sacc = __builtin_amdgcn_mfma_f32_16x16x32_bf16(kf, qf[ks], sacc, 0, 0, 0); }
        const int i = 16 * it + li;
#pragma unroll
        for (int r = 0; r < 4; ++r) { const int j = 16 * jt + 4 * g + r, dist = i > j ? i - j : j - i; sacc[r] *= __builtin_amdgcn_exp2f(lgam * (float)dist); }
        const unsigned lo = cvt_pk_bf16(sacc[0], sacc[1]), hi = cvt_pk_bf16(sacc[2], sacc[3]);
        const int base = 4 * (jt & 1);
        pf[jt >> 1][base + 0] = (short)(lo & 0xffffu); pf[jt >> 1][base + 1] = (short)(lo >> 16); pf[jt >> 1][base + 2] = (short)(hi & 0xffffu); pf[jt >> 1][base + 3] = (short)(hi >> 16);
    }
    f32x4 o[4];
#pragma unroll
    for (int et = 0; et < 4; ++et) {
        const int e0 = 64 * eh + 16 * et;
        f32x4 a = (f32x4){0.f, 0.f, 0.f, 0.f};
#pragma unroll
        for (int ks = 0; ks < 4; ++ks) { const bf16x8 sf = *(const bf16x8*)(STt + (e0 + li) * KTS + 64 * ks + 16 * g); a = __builtin_amdgcn_mfma_f32_16x16x32_bf16(qf[ks], sf, a, 0, 0, 0); }
#pragma unroll
        for (int r = 0; r < 4; ++r) a[r] *= __builtin_amdgcn_exp2f(lgam * (float)(16 * it + 4 * g + r + 1));
#pragma unroll
        for (int ks = 0; ks < 2; ++ks) { const bf16x8 vf = tr_frag(VT, KTS, 32 * ks, e0, lane); a = __builtin_amdgcn_mfma_f32_16x16x32_bf16(pf[ks], vf, a, 0, 0, 0); }
        o[et] = a;
    }
    float ps[4], pss[4];
#pragma unroll
    for (int r = 0; r < 4; ++r) { float s1 = 0.f, s2 = 0.f;
#pragma unroll
        for (int et = 0; et < 4; ++et) { s1 += o[et][r]; s2 += o[et][r] * o[et][r]; }
#pragma unroll
        for (int m = 1; m < 16; m <<= 1) { s1 += shfl_x(s1, lane, m); s2 += shfl_x(s2, lane, m); }
        ps[r] = s1; pss[r] = s2; }
    if (li == 0) {
#pragma unroll
        for (int r = 0; r < 4; ++r) *(f32x2*)(PS + (eh * 64 + 16 * it + 4 * g + r) * 2) = (f32x2){ps[r], pss[r]};
    }
    __syncthreads();
#pragma unroll
    for (int r = 0; r < 4; ++r) {
        const int p = 16 * it + 4 * g + r, row = chunk_row(b, n, p);
        const f32x2 oth = *(const f32x2*)(PS + ((eh ^ 1) * 64 + p) * 2);
        const float mean = (ps[r] + oth.x) * (1.f / 128.f);
        const float var = (pss[r] + oth.y) * (1.f / 128.f) - mean * mean;
        const float rstd = rsqrtf(fmaxf(var, 0.f) + LN_EPS);
        {
#pragma unroll
            for (int et = 0; et < 4; ++et) ((bf16_t*)KT)[p * (KTS / 2) + 64 * eh + 16 * et + li] = (bf16_t)f2bf((o[et][r] - mean) * rstd * ggv[et]);
        }
    }
    __syncthreads();
#pragma unroll
    for (int k = 0; k < 2; ++k) {
        const int idx = tid + 512 * k, p = idx >> 4, ch = idx & 15, row = chunk_row(b, n, p);
        const u32x4 y = *(const u32x4*)(KT + p * KTS + ch * 16), q = sgc[k];
        u32x4 w;
        w.x = cvt_pk_bf16(bf2f(y.x & 0xffffu) * bf2f(q.x & 0xffffu), bf2f(y.x >> 16) * bf2f(q.x >> 16));
        w.y = cvt_pk_bf16(bf2f(y.y & 0xffffu) * bf2f(q.y & 0xffffu), bf2f(y.y >> 16) * bf2f(q.y >> 16));
        w.z = cvt_pk_bf16(bf2f(y.z & 0xffffu) * bf2f(q.z & 0xffffu), bf2f(y.z >> 16) * bf2f(q.z >> 16));
        w.w = cvt_pk_bf16(bf2f(y.w & 0xffffu) * bf2f(q.w & 0xffffu), bf2f(y.w >> 16) * bf2f(q.w >> 16));
        if (row >= 0) *(u32x4*)(YC + (size_t)row * 1024 + 512 + h * 128 + ch * 8) = w;
    }
    __syncthreads();
}

#define XB_TMO      128
#define XB_XCNT(j)  (256  + 64 * (j))
#define XB_XSUB(j)  (1280 + 64 * (j))
#define XB_XGEN(j)  (2304 + 64 * (j))
#define XB_TOP      3328
#define XB_TOPGEN   3392
#define XCD_BAR_WORDS 3456
#define XB_SPIN_CAP (1u << 22)
__device__ __forceinline__ unsigned xb_ld(unsigned* p)              { return __hip_atomic_load(p, __ATOMIC_RELAXED, __HIP_MEMORY_SCOPE_AGENT); }
__device__ __forceinline__ unsigned xb_add(unsigned* p, unsigned v) { return __hip_atomic_fetch_add(p, v, __ATOMIC_RELAXED, __HIP_MEMORY_SCOPE_AGENT); }
__device__ __forceinline__ unsigned xb_xcc_id() { return (unsigned)__builtin_amdgcn_s_getreg((3 << 11) | 20) & 0xFu; }
#define XB_SPIN(cond, bar) do { unsigned _sp = 0; while (cond) { __builtin_amdgcn_s_sleep(1); \
    if ((++_sp & 255u) == 0u) { if (xb_ld(&(bar)[XB_TMO])) break; if (_sp > XB_SPIN_CAP) { atomicAdd(&(bar)[XB_TMO], 1u); break; } } } } while (0)
struct XcdBarrier { unsigned* bar; unsigned x; volatile LAS unsigned* st; };
__device__ __forceinline__ XcdBarrier xcd_barrier_post(unsigned* bar, volatile LAS unsigned* st) {
    XcdBarrier b; b.bar = bar; b.x = xb_xcc_id(); b.st = st;
    if (threadIdx.x == 0) (void)xb_add(&bar[XB_XCNT(b.x)], 1u);
    return b;
}
__device__ __forceinline__ void xcd_barrier_complete(unsigned* bar, unsigned x, unsigned& nloc, unsigned& nx) {
    const unsigned G = gridDim.x * gridDim.y * gridDim.z;
    unsigned sum, cnt, mine, sp = 0u;
    for (;;) {
        sum = 0u; cnt = 0u; mine = 0u;
#pragma unroll
        for (unsigned j = 0; j < 16; ++j) { const unsigned c = xb_ld(&bar[XB_XCNT(j)]); sum += c; cnt += (c > 0u) ? 1u : 0u; mine = (j == x) ? c : mine; }
        if (sum == G) break;
        __builtin_amdgcn_s_sleep(1);
        if ((++sp & 255u) == 0u) { if (xb_ld(&bar[XB_TMO])) break; if (sp > XB_SPIN_CAP) { atomicAdd(&bar[XB_TMO], 1u); break; } }
    }
    nloc = mine > 0u ? mine : 1u; nx = cnt > 0u ? cnt : 1u;
}
__device__ __forceinline__ void xcd_barrier(const XcdBarrier& b, const int wave_s) {
    asm volatile("s_waitcnt vmcnt(0)" ::: "memory");
    __syncthreads();
    if (wave_s == 0 && lane_id_v() == 0) {
        unsigned* bar = b.bar;
        asm volatile("" : "+s"(bar));
        __builtin_amdgcn_s_waitcnt(0);
        unsigned nloc = b.st[0], nx = b.st[1];
        if (nloc == 0u) { xcd_barrier_complete(bar, b.x, nloc, nx); b.st[0] = nloc; b.st[1] = nx; }
        const unsigned old = xb_add(&bar[XB_XSUB(b.x)], 1u);
        const unsigned gen = old / nloc;
        if (old + 1u == (gen + 1u) * nloc) {
            __builtin_amdgcn_fence(__ATOMIC_RELEASE, "agent");
            asm volatile("s_waitcnt vmcnt(0)" ::: "memory");
            const unsigned og = xb_add(&bar[XB_TOP], 1u);
            const unsigned tg = og / nx;
            if (og + 1u == (tg + 1u) * nx) xb_add(&bar[XB_TOPGEN], 1u);
            else XB_SPIN(xb_ld(&bar[XB_TOPGEN]) == tg, bar);
            __builtin_amdgcn_fence(__ATOMIC_ACQUIRE, "agent");
            xb_add(&bar[XB_XGEN(b.x)], 1u);
            asm volatile("s_waitcnt vmcnt(0)" ::: "memory");
        } else {
            XB_SPIN(xb_ld(&bar[XB_XGEN(b.x)]) == gen, bar);
            __builtin_amdgcn_fence(__ATOMIC_ACQUIRE, "agent");
            asm volatile("s_waitcnt vmcnt(0)" ::: "memory");
        }
    }
    __syncthreads();
}

__device__ __forceinline__ void cvt_item(const float* src, int K, int Nsrc, bf16_t* dst, int Kp, int Nd, int type, const float* g, const float* b, cfix_t* c1, cfix_t* c2, int item, float* scr, int lane) {
    const int nblk = Nd / 32, kb = item / nblk, nb = item % nblk, k0 = 64 * kb, n0 = 32 * nb;
    int sc = n0; bool valid = true;
    const int pn = n0 >> 8, bj = (n0 >> 7) & 1, cc = n0 & 127;
    if (type == 0) { const int gcol = 128 * pn + cc; valid = gcol < DFF; sc = bj ? DFF + gcol : gcol; }
    else if (type == 2) {
        if (pn == 0 || pn >= 7) sc = n0;
        else if (pn <= 2) sc = 256 + 256 * bj + 128 * (pn - 1) + cc;
        else { const int base = pn <= 4 ? 768 : 1280, head = 2 * ((pn - 3) & 1) + (cc >> 6); sc = base + 128 * head + 64 * bj + (cc & 63); }
    }
    float a1 = 0.f, a2 = 0.f;
    float vv[32];
#pragma unroll
    for (int i = 0; i < 32; ++i) { const int k = k0 + 2 * i + (lane >> 5); vv[i] = (valid && k < K) ? src[(size_t)k * Nsrc + sc + (lane & 31)] : 0.f; }
#pragma unroll
    for (int i = 0; i < 32; ++i) {
        const int kk = 2 * i + (lane >> 5), k = k0 + kk;
        float v = vv[i];
        if (g) { a2 += b[k] * v; v *= g[k]; a1 += bf2f(f2bf(v)); }
        scr[kk * 33 + (lane & 31)] = v;
    }
    if (g) { a1 += shfl_x(a1, lane, 32); a2 += shfl_x(a2, lane, 32); if (lane < 32) { atomicAdd((unsigned long long*)(c1 + n0 + lane), (unsigned long long)(cfix_t)llrintf(a1 * 4294967296.0f)); atomicAdd((unsigned long long*)(c2 + n0 + lane), (unsigned long long)(cfix_t)llrintf(a2 * 4294967296.0f)); } }
    asm volatile("s_waitcnt lgkmcnt(0)" ::: "memory");
    const int c = lane & 7;
#pragma unroll
    for (int j = 0; j < 4; ++j) { const int n = (lane >> 3) + 8 * j; const float* s = scr + (8 * c) * 33 + n;
        u32x4 o; o.x = cvt_pk_bf16(s[0 * 33], s[1 * 33]); o.y = cvt_pk_bf16(s[2 * 33], s[3 * 33]); o.z = cvt_pk_bf16(s[4 * 33], s[5 * 33]); o.w = cvt_pk_bf16(s[6 * 33], s[7 * 33]);
        *(u32x4*)(dst + (size_t)(n0 + n) * Kp + k0 + 8 * c) = o; }
    asm volatile("s_waitcnt lgkmcnt(0)" ::: "memory");
}
__device__ __forceinline__ void cvt_job(const float* src, int K, int Nsrc, bf16_t* dst, int Kp, int Nd, int type, const float* g, const float* b, cfix_t* c1, cfix_t* c2, float* scr, int gw, int NGW, int lane) {
    const int nitems = (Kp / 64) * (Nd / 32);
    for (int it = gw; it < nitems; it += NGW) cvt_item(src, K, Nsrc, dst, Kp, Nd, type, g, b, c1, c2, it, scr, lane);
}

struct Args { const float* in[20]; float* out; unsigned char* ws; int ph_lo, ph_hi, use_cg, pad; };

#define INP(i) ((const float*)(((unsigned long long)(unsigned)__builtin_amdgcn_readfirstlane((int)ptab[2 * (i) + 1]) << 32) | (unsigned long long)(unsigned)__builtin_amdgcn_readfirstlane((int)ptab[2 * (i)])))
template <bool PRO, bool MID, int MASK>
__device__ __forceinline__ void run_phase(const Args& a, unsigned char* smem, volatile LAS unsigned* ptab_in, const int ph, const int G, const int NGW, const int NTH, const int wave_s) {
        unsigned pt_ = (unsigned)(unsigned long long)ptab_in; asm volatile("" : "+s"(pt_));
        volatile LAS unsigned* ptab = (volatile LAS unsigned*)(unsigned long long)pt_;
        unsigned char* ws = a.ws; float* zf = a.out;
        asm volatile("" : "+s"(ws), "+s"(zf));
        int bid = blockIdx.x;
        asm volatile("" : "+s"(bid));
        const int wave = wave_s;
#define TID_SETUP int tid = wave_s * 64 + lane_id_v(); const int lane = tid & 63, gw = bid * 8 + wave, gtid = bid * 512 + tid; (void)lane; (void)gw; (void)gtid;
        const float* x = INP(0); const float* meta = INP(1);
        float* zfm = (float*)(ws + OFF_ZFM);
        float* stats0 = (float*)(ws + OFF_STATS); float* stats1 = (float*)(ws + OFF_STATS + STATS_BYTES);
        float* rope = (float*)(ws + OFF_ROPE);
        cfix_t* cvec = (cfix_t*)(ws + OFF_CVEC);
        bf16_t* zb = (bf16_t*)(ws + OFF_ZB);
        bf16_t* Gb = (bf16_t*)(ws + OFF_G);
        bf16_t *XP = (bf16_t*)(ws + OFF_XP), *U = (bf16_t*)(ws + OFF_U), *Q = (bf16_t*)(ws + OFF_Q), *Kb = (bf16_t*)(ws + OFF_K), *K2 = (bf16_t*)(ws + OFF_K2), *V = (bf16_t*)(ws + OFF_V), *SG = (bf16_t*)(ws + OFF_SG);
        bf16_t* YC = (bf16_t*)(ws + OFF_YCAT); bf16_t* ST = (bf16_t*)(ws + OFF_ST);
        bf16_t* WA13 = (bf16_t*)(ws + OFF_WA); bf16_t* WA2 = (bf16_t*)(ws + OFF_WA + W13_BYTES);
        bf16_t* WB13 = (bf16_t*)(ws + OFF_WB); bf16_t* WB2 = (bf16_t*)(ws + OFF_WB + W13_BYTES);
        const float* ln_g = INP(18); const float* ln_b = INP(19);
        float* scr = (float*)(smem + wave * 8704);
        if (PRO && (MASK & 1) && ph == 0) {
            TID_SETUP
            cvt_job(INP(4), 1024, 2 * DFF, WA13, 1024, NUP, 0, INP(2), INP(3), cvec + 0, cvec + 5632, scr, gw, NGW, lane);
            cvt_job(INP(5), DFF, 1024, WA2, GW, 1024, 1, nullptr, nullptr, nullptr, nullptr, scr, gw, NGW, lane);
            for (int l = 0; l < 2; ++l) {
                cvt_job(INP(13) + (size_t)l * 65536, 256, 256, (bf16_t*)(ws + OFF_PW) + (size_t)l * 65536, 256, 256, 1, nullptr, nullptr, nullptr, nullptr, scr, gw, NGW, lane);
                bf16_t* ppt = (bf16_t*)(ws + OFF_PP) + (size_t)l * 65536; const float* pw = INP(7) + (size_t)l * 16384; const float* psc = INP(8) + l * 256;
                for (int idx = gtid; idx < 65536; idx += NTH) { const int n = idx >> 8, kk = idx & 255;
                    ppt[idx] = (bf16_t)((kk >> 6) == (n >> 6) ? f2bf(pw[(size_t)((n >> 6) * 64 + (kk & 63)) * 64 + (n & 63)] * psc[n]) : 0u); }
            }
            for (int r0 = gw; r0 < T; r0 += 2 * NGW) {
                const int r1 = r0 + NGW; const bool two = r1 < T; const int r1c = two ? r1 : r0;
                const float* s0 = r0 < TM ? x + (size_t)r0 * 1024 : meta + (size_t)((r0 - TM) & 15) * 1024;
                const float* s1 = r1c < TM ? x + (size_t)r1c * 1024 : meta + (size_t)((r1c - TM) & 15) * 1024;
                f32x4 v[4], w4[4]; float sa = 0.f, ssa = 0.f, sb = 0.f, ssb = 0.f;
#pragma unroll
                for (int j = 0; j < 4; ++j) { v[j] = ((const f32x4*)s0)[lane + 64 * j]; w4[j] = ((const f32x4*)s1)[lane + 64 * j]; }
#pragma unroll
                for (int j = 0; j < 4; ++j) { sa += (v[j].x + v[j].y) + (v[j].z + v[j].w); ssa += (v[j].x * v[j].x + v[j].y * v[j].y) + (v[j].z * v[j].z + v[j].w * v[j].w);
                                              sb += (w4[j].x + w4[j].y) + (w4[j].z + w4[j].w); ssb += (w4[j].x * w4[j].x + w4[j].y * w4[j].y) + (w4[j].z * w4[j].z + w4[j].w * w4[j].w); }
#pragma unroll
                for (int o = 1; o < 64; o <<= 1) { sa += shfl_x(sa, lane, o); ssa += shfl_x(ssa, lane, o); sb += shfl_x(sb, lane, o); ssb += shfl_x(ssb, lane, o); }
#pragma unroll
                for (int j = 0; j < 4; ++j) { u32x2 w; w.x = cvt_pk_bf16(v[j].x, v[j].y); w.y = cvt_pk_bf16(v[j].z, v[j].w); ((u32x2*)(zb + (size_t)r0 * 1024))[lane + 64 * j] = w; }
                if (lane < 16) ((f32x2*)(stats0 + (size_t)r0 * 32))[lane] = lane == 0 ? (f32x2){sa, ssa} : (f32x2){0.f, 0.f};
                if (two) {
#pragma unroll
                    for (int j = 0; j < 4; ++j) { u32x2 w; w.x = cvt_pk_bf16(w4[j].x, w4[j].y); w.y = cvt_pk_bf16(w4[j].z, w4[j].w); ((u32x2*)(zb + (size_t)r1 * 1024))[lane + 64 * j] = w; }
                    if (lane < 16) ((f32x2*)(stats0 + (size_t)r1 * 32))[lane] = lane == 0 ? (f32x2){sb, ssb} : (f32x2){0.f, 0.f};
                }
            }
            for (int idx = gtid; idx < LSEQ * 64; idx += NTH) {
                const int t = idx >> 6, i = idx & 63;
                const double inv = exp2(-(double)i * (13.287712379549449 / 64.0));
                double sn, cs; sincos((double)t * inv, &sn, &cs);
                ((f32x2*)rope)[idx] = (f32x2){(float)cs, (float)sn};
            }
        } else if (PRO && (MASK & 1) && ph == -1) {
            TID_SETUP
            const float* fg = ln_g + 5 * 1024; const float* fb = ln_b + 5 * 1024;
            for (int r = gw; r < TM; r += NGW) {
                f32x4* p = (f32x4*)(zf + (size_t)r * 1024); f32x4 v[4]; float s = 0.f;
#pragma unroll
                for (int j = 0; j < 4; ++j) { v[j] = p[lane + 64 * j]; s += (v[j].x + v[j].y) + (v[j].z + v[j].w); }
                const float mean = wave_sum(s, lane) * (1.f / 1024.f); float s2 = 0.f;
#pragma unroll
                for (int j = 0; j < 4; ++j) { v[j] = v[j] - mean; s2 += (v[j].x * v[j].x + v[j].y * v[j].y) + (v[j].z * v[j].z + v[j].w * v[j].w); }
                const float rstd = rsqrtf(wave_sum(s2, lane) * (1.f / 1024.f) + LN_EPS);
#pragma unroll
                for (int j = 0; j < 4; ++j) { const f32x4 gg = ((const f32x4*)fg)[lane + 64 * j], bb = ((const f32x4*)fb)[lane + 64 * j]; p[lane + 64 * j] = v[j] * rstd * gg + bb; }
            }
        } else if (MID) {
            const int q = ph - 1, l = q / 9, k = q - 9 * l;
            const int par = (3 * l + (k > 1 ? 1 : 0) + (k > 6 ? 1 : 0)) & 1;
            const float* sprev = par ? stats1 : stats0; float* snew = par ? stats0 : stats1;
            cfix_t* cv = cvec + l * 28160;
            bf16_t* win = (bf16_t*)(ws + (l ? OFF_WIO1 : OFF_WIO0)); bf16_t* wout = (bf16_t*)(ws + (l ? OFF_WIO1 : OFF_WIO0) + WIN_BYTES);
            if ((MASK & 2) && (k == 0 || k == 7)) {
                TID_SETUP
                pg8::Gemm g{zb, k == 0 ? WA13 : WB13, 1024}; pg8::StaticOrder S; S.init(TM, NUP, G, bid);
                const LAS float* ctab = (const LAS float*)((LAS unsigned char*)smem + CTAB_OFF);
                {
                    const cfix_t* cc1 = cv + (k == 0 ? 0 : 16896); const cfix_t* cc2 = cv + (k == 0 ? 5632 : 22528);
                    for (int i = 0; i < 6; ++i) { pg8::Unit uu; if (!S.next(i, uu)) break;
                        ((LAS float*)ctab)[i * 512 + tid] = cfix2f((tid < 256 ? cc1 : cc2)[uu.pn * 256 + (tid & 255)]); }
                    __syncthreads();
                }
                EpiUp E{sprev, cv + (k == 0 ? 0 : 16896), cv + (k == 0 ? 5632 : 22528), ws, ctab};
                pg8::gemm_phase<EpiUp>((LAS unsigned char*)smem, g, S, E, tid);
                tail_units<EpiUp>(smem, zb + (size_t)TM * 1024, g.Bt, 1024, NUP / 64, S.nwg % G, E, wave_s * 64 + lane_id_v(), bid);
                if (bid >= 128 && (k == 0 || (l == 0 && k == 7))) {
                    const int gw2 = (bid - 128) * 8 + wave, NGW2 = 128 * 8; const int ln2 = lane_id_v();
                    if (k == 0) {
                        cvt_job(INP(16) + (size_t)l * 1024 * 2 * DFF, 1024, 2 * DFF, WB13, 1024, NUP, 0, ln_g + (3 * l + 1) * 1024, ln_b + (3 * l + 1) * 1024, cv + 16896, cv + 22528, scr, gw2, NGW2, ln2);
                        cvt_job(INP(17) + (size_t)l * DFF * 1024, DFF, 1024, WB2, GW, 1024, 1, nullptr, nullptr, nullptr, nullptr, scr, gw2, NGW2, ln2);
                        if (l == 0) {
                            cvt_job(INP(6), 1024, DIN, win, 1024, DIN, 2, ln_g, ln_b, cv + 11264, cv + 14080, scr, gw2, NGW2, ln2);
                            cvt_job(INP(15), 1024, 1024, wout, 1024, 1024, 1, nullptr, nullptr, nullptr, nullptr, scr, gw2, NGW2, ln2);
                        }
                    } else {
                        cvt_job(INP(4) + (size_t)1024 * 2 * DFF, 1024, 2 * DFF, WA13, 1024, NUP, 0, ln_g + 2 * 1024, ln_b + 2 * 1024, cvec + 28160 + 0, cvec + 28160 + 5632, scr, gw2, NGW2, ln2);
                        cvt_job(INP(5) + (size_t)DFF * 1024, DFF, 1024, WA2, GW, 1024, 1, nullptr, nullptr, nullptr, nullptr, scr, gw2, NGW2, ln2);
                    }
                }
            } else if ((MASK & 4) && (k == 1 || k == 6 || k == 8)) {
                TID_SETUP
                const bool isout = k == 6;
                const int lni = k == 1 ? (l == 0 ? -1 : 2) : (k == 6 ? 3 * l + 0 : 3 * l + 1);
                const float* lg = lni < 0 ? INP(2) : ln_g + lni * 1024; const float* lb = lni < 0 ? INP(3) : ln_b + lni * 1024;
                const bf16_t* Amat = isout ? YC : Gb; const int Kd = isout ? 1024 : GW;
                const bf16_t* Bt = isout ? wout : (k == 1 ? WA2 : WB2);
                pg8::Gemm g{Amat, Bt, Kd}; pg8::StaticOrder S; S.init(TM, 1024, G, bid);
                const LAS float* ctab = (const LAS float*)((LAS unsigned char*)smem + CTAB_OFF);
                {
                    pg8::Unit uu; if (S.next(0, uu)) { const int cc = uu.pn * 256 + (tid & 255);
                        ((LAS float*)ctab)[tid] = (tid < 256 ? lg : lb)[cc]; ((LAS float*)ctab)[512 + tid] = (tid < 256 ? ln_g + 5 * 1024 : ln_b + 5 * 1024)[cc]; }
                    __syncthreads();
                }
                EpiRes E{sprev, snew, lg, lb, zf, ws, isout ? 1.0f : 0.5f,
                         (l == 1 && k == 8) ? 1 : 0, ln_g + 5 * 1024, ln_b + 5 * 1024, (unsigned*)(ws + OFF_CTL + 14336), ctab};
                pg8::gemm_phase<EpiRes>((LAS unsigned char*)smem, g, S, E, tid);
                if (!E.fin) tail_units<EpiRes>(smem, Amat + (size_t)TM * Kd, Bt, Kd, 16, S.nwg % G, E, wave_s * 64 + lane_id_v(), bid);
            } else if ((MASK & 8) && k == 2) {
                TID_SETUP
                pg8::Gemm g{zb, win, 1024}; pg8::StaticOrder S; S.init(TM, DIN, G, bid);
                const LAS float* ctab = (const LAS float*)((LAS unsigned char*)smem + CTAB_OFF);
                {
                    const cfix_t* cc1 = cv + 11264; const cfix_t* cc2 = cv + 14080;
                    for (int i = 0; i < 3; ++i) { pg8::Unit uu; if (!S.next(i, uu)) break;
                        ((LAS float*)ctab)[i * 512 + tid] = cfix2f((tid < 256 ? cc1 : cc2)[uu.pn * 256 + (tid & 255)]); }
                    __syncthreads();
                }
                EpiIn E{sprev, cv + 11264, cv + 14080, ws, ctab};
                pg8::gemm_phase<EpiIn>((LAS unsigned char*)smem, g, S, E, tid);
                tail_units<EpiIn>(smem, zb + (size_t)TM * 1024, win, 1024, DIN / 64, S.nwg % G, E, wave_s * 64 + lane_id_v(), bid);
                if (l == 0 && bid >= 192) {
                    const int gw2 = (bid - 192) * 8 + wave, NGW2 = 64 * 8; const int ln2 = lane_id_v();
                    cvt_job(INP(6) + (size_t)1024 * DIN, 1024, DIN, (bf16_t*)(ws + OFF_WIO1), 1024, DIN, 2, ln_g + 3 * 1024, ln_b + 3 * 1024, cvec + 28160 + 11264, cvec + 28160 + 14080, scr, gw2, NGW2, ln2);
                    cvt_job(INP(15) + (size_t)1024 * 1024, 1024, 1024, (bf16_t*)(ws + OFF_WIO1 + WIN_BYTES), 1024, 1024, 1, nullptr, nullptr, nullptr, nullptr, scr, gw2, NGW2, ln2);
                }
            } else if ((MASK & 16) && k == 3) {
                TID_SETUP
                const bf16_t* PWT = (const bf16_t*)(ws + OFF_PW) + (size_t)l * 65536; const bf16_t* PPT = (const bf16_t*)(ws + OFF_PP) + (size_t)l * 65536;
                const float* dw = INP(9) + (size_t)l * 31 * 256; const float* db = INP(10) + l * 256;
                const float* cg_ = INP(11) + l * 256; const float* cb_ = INP(12) + l * 256;
                constexpr int NCV = 258, NPL = 258, NKV = 1024;
                for (int j = 0; j < 7; ++j) {
                    int it = -1; bool pair = false;
                    if (j == 0) it = bid;
                    else if (j == 1) { if (bid < 2) it = 256 + bid; }
                    else if (j == 2) it = NCV + bid;
                    else if (j == 3) { if (bid >= 2 && bid < 4) it = NCV + 256 + (bid - 2); }
                    else if (j < 6) { pair = true; if (bid >= 4) it = NCV + NPL + 4 * (bid - 4) + 2 * (j - 4); else if (bid >= 2 && j == 4) it = NCV + NPL + 1008 + 2 * (bid - 2); }
                    else { if (bid >= 4 && bid < 16) it = NCV + NPL + 1012 + (bid - 4); }
                    if (it < 0) continue;
                    asm volatile("" : "+v"(tid));
                    if (it < NCV) conv_item(smem, U, PWT, dw, db, cg_, cb_, YC, it / 129, it % 129, tid);
                    else if (it < NCV + NPL) pool_item(smem, XP, PPT, YC, (it - NCV) / 129, (it - NCV) % 129, tid);
                    else { const int kk = it - NCV - NPL; if (pair) kv_item<2>(smem, Kb, V, ST, kk >> 7, kk & 127, tid); else kv_item<1>(smem, Kb, V, ST, kk >> 7, kk & 127, tid); }
                }
            } else if ((MASK & 64) && k == 4) {
                TID_SETUP
                {
                    const int d = gtid & 127, e = (gtid >> 7) & 127, bh = gtid >> 14, h = bh & 3;
                    const float g64 = exp2f(64.f * log2_gamma(h));
                    bf16_t* p = ST + (size_t)bh * NCHUNK * 16384 + e * 128 + d;
                    float Sv = 0.f;
#pragma unroll 1
                    for (int n0 = 0; n0 < NCHUNK - 1; n0 += 32) {
                        unsigned short kvb[32];
#pragma unroll
                        for (int j = 0; j < 32; ++j) kvb[j] = p[(size_t)(n0 + j) * 16384];
#pragma unroll
                        for (int j = 0; j < 32; ++j) { p[(size_t)(n0 + j) * 16384] = (bf16_t)f2bf(Sv); Sv = g64 * Sv + bf2f(kvb[j]); }
                    }
                    p[(size_t)(NCHUNK - 1) * 16384] = (bf16_t)f2bf(Sv);
                }
            } else if ((MASK & 32) && k == 5) {
                TID_SETUP
                const float* gng = INP(14) + l * 512;
                RetRegs R;
                { const int bh0 = bid < 1024 ? (bid >> 7) : (bid - 1024), n0_ = bid < 1024 ? 1 + (bid & 127) : 0; ret_load(R, Q, Kb, V, ST, SG, bh0, n0_, tid); }
                for (int it = bid; it < 1032; it += G) {
                    const int bh = it < 1024 ? (it >> 7) : (it - 1024), n = it < 1024 ? 1 + (it & 127) : 0;
                    const int itn = it + G; const bool hn = itn < 1032;
                    const int nbh = itn < 1024 ? (itn >> 7) : (itn - 1024), nn = itn < 1024 ? 1 + (itn & 127) : 0;
                    ret_item(smem, R, Q, Kb, V, ST, SG, gng, YC, bh, n, hn, hn ? nbh : bh, hn ? nn : n, tid);
                }
            }
        }
}

template <int MASK>
__global__ void __launch_bounds__(512, 2) mk_fwd(Args a) {
    extern __shared__ __attribute__((aligned(16))) unsigned char smem[];
    constexpr int G = GRID, NGW = G * 8, NTH = G * 512;
    volatile LAS unsigned* misc = (volatile LAS unsigned*)((LAS unsigned char*)smem + MISC_OFF);
    if (threadIdx.x < 64) misc[threadIdx.x] = 0u;
    volatile LAS unsigned* ptab = misc + 64;
    if (threadIdx.x == 0) {
#pragma unroll
        for (int i = 0; i < 20; ++i) { const unsigned long long p = (unsigned long long)a.in[i]; ptab[2 * i] = (unsigned)p; ptab[2 * i + 1] = (unsigned)(p >> 32); }
    }
    __syncthreads();
    XcdBarrier bar = xcd_barrier_post((unsigned*)(a.ws + OFF_CTL), misc + 8);
    const int wave_s = __builtin_amdgcn_readfirstlane((int)(threadIdx.x >> 6));
    if (a.ph_lo <= 0 && a.ph_hi > 0) {
        run_phase<true, false, MASK>(a, smem, ptab, 0, G, NGW, NTH, wave_s);
        if (a.ph_hi > 1) { if (a.use_cg) cg::this_grid().sync(); else xcd_barrier(bar, wave_s); }
    }
    for (int ph = (a.ph_lo > 1 ? a.ph_lo : 1); ph < (a.ph_hi < NPH ? a.ph_hi : NPH); ++ph) {
        if (ph > 1 && ph > a.ph_lo) xcd_barrier(bar, wave_s);
        run_phase<false, true, MASK>(a, smem, ptab, ph, G, NGW, NTH, wave_s);
    }
}

template <int MASK> static void launch_plain(const Args& a, int grid, hipStream_t stream) {
    static bool attr = false;
    if (!attr) { (void)hipFuncSetAttribute((const void*)mk_fwd<MASK>, hipFuncAttributeMaxDynamicSharedMemorySize, LDS_BYTES); attr = true; }
    hipLaunchKernelGGL(mk_fwd<MASK>, dim3(grid), dim3(512), LDS_BYTES, stream, a);
}
extern "C" void kernel_launch(void* const* d_in, const int* in_sizes, int n_in, void* d_out, int out_size, void* d_ws, size_t ws_size, hipStream_t stream) {
    static int grid = 0;
    if (grid == 0) {
        if (n_in != 20 || out_size != TM * D || ws_size < WS_END) { fprintf(stderr, "kernel_launch: unexpected shapes (n_in %d, out %d, ws %zu, need %zu)\n", n_in, out_size, ws_size, (size_t)WS_END); grid = -1; return; }
        int dev = 0, cus = 0;
        (void)hipGetDevice(&dev); (void)hipDeviceGetAttribute(&cus, hipDeviceAttributeMultiprocessorCount, dev);
#if ONE_LAUNCH
        if (hipFuncSetAttribute((const void*)mk_fwd<127>, hipFuncAttributeMaxDynamicSharedMemorySize, LDS_BYTES) != hipSuccess) { fprintf(stderr, "kernel_launch: hipFuncSetAttribute failed\n"); grid = -1; return; }
#endif
        grid = GRID;
        if (cus != GRID) fprintf(stderr, "kernel_launch: warning: %d CUs, kernel built for %d\n", cus, GRID);
    }
    if (grid < 0) return;
    (void)hipMemsetAsync(d_ws, 0, ZERO_BYTES, stream);
    Args a{};
    for (int i = 0; i < 20; ++i) a.in[i] = (const float*)d_in[i];
    a.out = (float*)d_out; a.ws = (unsigned char*)d_ws; a.use_cg = 0; a.pad = 0;
#if ONE_LAUNCH
    a.ph_lo = 0; a.ph_hi = NPH;
    void* args[] = {&a};
    hipError_t e = hipLaunchCooperativeKernel((const void*)mk_fwd<127>, dim3(grid), dim3(512), args, LDS_BYTES, stream);
    if (e != hipSuccess) fprintf(stderr, "cooperative launch failed: %s (grid %d)\n", hipGetErrorString(e), grid);
#if PROBE_SET
    {
        static bool attr = false;
        if (!attr) { (void)hipFuncSetAttribute((const void*)mk_fwd<127>, hipFuncAttributeMaxDynamicSharedMemorySize, LDS_BYTES); attr = true; }
        for (int ph = 1; ph < NPH; ++ph) {
            const int k = (ph - 1) % 9;
            const bool sel = PROBE_SET == 1 ? (k == 0 || k == 7 || k == 2) : PROBE_SET == 2 ? (k == 3 || k == 4 || k == 5) : PROBE_SET == 3 ? (k == 0 || k == 7) : PROBE_SET == 4 ? (k == 3) : PROBE_SET == 5 ? (k == 4) : (k == 5);
            if (!sel) continue;
            a.ph_lo = ph; a.ph_hi = ph + 1;
            hipLaunchKernelGGL(mk_fwd<127>, dim3(grid), dim3(512), LDS_BYTES, stream, a);
        }
    }
#endif
#else
    for (int ph = 0; ph < NPH; ++ph) {
        a.ph_lo = ph; a.ph_hi = ph + 1;
        if (ph == 0) { launch_plain<1>(a, grid, stream); continue; }
        const int k = (ph - 1) % 9;
        if (k == 0 || k == 7) launch_plain<2>(a, grid, stream);
        else if (k == 1 || k == 6 || k == 8) launch_plain<4>(a, grid, stream);
        else if (k == 2) launch_plain<8>(a, grid, stream);
        else if (k == 3) launch_plain<16>(a, grid, stream);
        else if (k == 4) launch_plain<64>(a, grid, stream);
        else launch_plain<32>(a, grid, stream);
    }
#endif
}
```
